# Optimizing an MI355X kernel written in HIP

```python
import math
import jax
import jax.numpy as jnp
from jax import lax
import numpy as np

D_MODEL = 1024
BATCH = 8
SEQ = 4096
DEPTH = 2

D_MIX = D_MODEL
ATTN_HEADS = 8
HEAD_DIM = 64
D_ATTN = ATTN_HEADS * HEAD_DIM
D_SSM = D_MIX // 4
SSM_GROUP = 16
SSM_GROUPS = D_SSM // SSM_GROUP
SSM_STATE = 64
D_CONV = D_MIX - D_ATTN - D_SSM
CONV_WIDTH = 31
ROT_DIM = HEAD_DIM // 4
ROPE_THETA = 500000.0
MOBA_BLOCK = 256
MOBA_TOPK = 3
MOBA_QCHUNK = 32
D_FF = ((8 * D_MODEL + 3 * 256 - 1) // (3 * 256)) * 256
D_IN = 3 * D_ATTN + D_SSM + 2 * D_CONV
SPLITS = (D_ATTN, 2 * D_ATTN, 3 * D_ATTN, 3 * D_ATTN + D_SSM, 3 * D_ATTN + D_SSM + D_CONV)
RMS_EPS = 1e-6
LN_EPS = 1e-5

kernel_name = "hymba_moba_s5_conformer_hybrid"


def rms_norm(x, g):
    xf = x.astype(jnp.float32)
    y = xf * lax.rsqrt(jnp.mean(xf * xf, axis=-1, keepdims=True) + RMS_EPS)
    return (y * g.astype(jnp.float32)).astype(x.dtype)


def layer_norm(x, g, b):
    xf = x.astype(jnp.float32)
    mu = jnp.mean(xf, axis=-1, keepdims=True)
    xc = xf - mu
    y = xc * lax.rsqrt(jnp.mean(xc * xc, axis=-1, keepdims=True) + LN_EPS)
    return (y * g.astype(jnp.float32) + b.astype(jnp.float32)).astype(x.dtype)


def rope_tables(seq):
    inv = jnp.power(ROPE_THETA, -jnp.arange(0, ROT_DIM, 2, dtype=jnp.float32) / ROT_DIM)
    ang = jnp.arange(seq, dtype=jnp.float32)[:, None] * inv[None, :]
    return jnp.cos(ang), jnp.sin(ang)


def apply_partial_rope(t, cos, sin):
    half = ROT_DIM // 2
    c = cos.astype(t.dtype)
    s = sin.astype(t.dtype)
    t1 = t[..., :half]
    t2 = t[..., half:ROT_DIM]
    return jnp.concatenate([t1 * c - t2 * s, t2 * c + t1 * s, t[..., ROT_DIM:]], axis=-1)


def split_heads(t, bsz, seq):
    return t.reshape(bsz, seq, ATTN_HEADS, HEAD_DIM).transpose(0, 2, 1, 3)


def moba_attention(q, k, v):
    f32 = jnp.float32
    bsz, nh, seq, dh = q.shape
    nb = -(-seq // MOBA_BLOCK)
    pad = nb * MOBA_BLOCK - seq
    kp = jnp.pad(k, ((0, 0), (0, 0), (0, pad), (0, 0)))
    vp = jnp.pad(v, ((0, 0), (0, 0), (0, pad), (0, 0)))
    k_blocks = kp.reshape(bsz, nh, nb, MOBA_BLOCK, dh)
    v_blocks = vp.reshape(bsz, nh, nb, MOBA_BLOCK, dh)
    k_mean = jnp.mean(k_blocks.astype(f32), axis=3)
    topk = min(MOBA_TOPK, max(nb - 1, 1))
    scale = HEAD_DIM ** -0.5
    n_chunks = seq // MOBA_QCHUNK
    key_off = jnp.arange(MOBA_BLOCK)
    block_ids = jnp.arange(nb)
    gather = jax.vmap(jax.vmap(lambda blocks, idx: blocks[idx]))

    def chunk(ci):
        q0 = ci * MOBA_QCHUNK
        qc = lax.dynamic_slice_in_dim(q, q0, MOBA_QCHUNK, axis=2).astype(f32)
        qpos = q0 + jnp.arange(MOBA_QCHUNK)
        own = q0 // MOBA_BLOCK
        gate = jnp.einsum('bhqd,bhnd->bhqn', qc, k_mean)
        gate = jnp.where(block_ids < own, gate, -jnp.inf)
        _, sel = lax.top_k(gate, topk)
        sel_valid = jnp.arange(topk) < own
        k_sel = gather(k_blocks, sel).astype(f32)
        v_sel = gather(v_blocks, sel).astype(f32)
        k_own = lax.dynamic_index_in_dim(k_blocks, own, axis=2, keepdims=False).astype(f32)
        v_own = lax.dynamic_index_in_dim(v_blocks, own, axis=2, keepdims=False).astype(f32)
        s_sel = jnp.einsum('bhqd,bhqnkd->bhqnk', qc, k_sel) * scale
        s_sel = jnp.where(sel_valid[:, None], s_sel, -jnp.inf)
        s_sel = s_sel.reshape(bsz, nh, MOBA_QCHUNK, topk * MOBA_BLOCK)
        s_own = jnp.einsum('bhqd,bhkd->bhqk', qc, k_own) * scale
        causal = (own * MOBA_BLOCK + key_off)[None, :] <= qpos[:, None]
        s_own = jnp.where(causal, s_own, -jnp.inf)
        p = jax.nn.softmax(jnp.concatenate([s_own, s_sel], axis=-1), axis=-1)
        p_own = p[..., :MOBA_BLOCK]
        p_sel = p[..., MOBA_BLOCK:].reshape(bsz, nh, MOBA_QCHUNK, topk, MOBA_BLOCK)
        o = (jnp.einsum('bhqk,bhkd->bhqd', p_own, v_own)
             + jnp.einsum('bhqnk,bhqnkd->bhqd', p_sel, v_sel))
        return o.astype(q.dtype)

    out = lax.map(chunk, jnp.arange(n_chunks))
    return out.transpose(1, 2, 0, 3, 4).reshape(bsz, nh, seq, dh)


def s5_mixer(u, lam_re, lam_im, log_dt, b_re, b_im, c_re, c_im, d_skip, w_glu, b_glu):
    f32 = jnp.float32
    bsz, seq, _ = u.shape
    uf = u.astype(f32).reshape(bsz, seq, SSM_GROUPS, SSM_GROUP)
    dt = jnp.exp(log_dt.astype(f32))[:, None]
    lr = lam_re.astype(f32)
    li = lam_im.astype(f32)
    mag = jnp.exp(lr * dt)
    ab_re = mag * jnp.cos(li * dt)
    ab_im = mag * jnp.sin(li * dt)
    nr = ab_re - 1.0
    den = lr * lr + li * li
    f_re = (nr * lr + ab_im * li) / den
    f_im = (ab_im * lr - nr * li) / den
    br = b_re.astype(f32)
    bi = b_im.astype(f32)
    bb_re = f_re[..., None] * br - f_im[..., None] * bi
    bb_im = f_re[..., None] * bi + f_im[..., None] * br
    x_re = jnp.einsum('bsgc,gpc->bsgp', uf, bb_re)
    x_im = jnp.einsum('bsgc,gpc->bsgp', uf, bb_im)
    a_re = jnp.broadcast_to(ab_re, (1, seq, SSM_GROUPS, SSM_STATE))
    a_im = jnp.broadcast_to(ab_im, (1, seq, SSM_GROUPS, SSM_STATE))

    def combine(left, right):
        a1r, a1i, b1r, b1i = left
        a2r, a2i, b2r, b2i = right
        return (a2r * a1r - a2i * a1i,
                a2r * a1i + a2i * a1r,
                a2r * b1r - a2i * b1i + b2r,
                a2r * b1i + a2i * b1r + b2i)

    _, _, h_re, h_im = lax.associative_scan(combine, (a_re, a_im, x_re, x_im), axis=1)
    y = (jnp.einsum('bsgp,gcp->bsgc', h_re, c_re.astype(f32))
         - jnp.einsum('bsgp,gcp->bsgc', h_im, c_im.astype(f32))
         + d_skip.astype(f32) * uf)
    z = jax.nn.gelu(y.reshape(bsz, seq, D_SSM))
    out = z * jax.nn.sigmoid(z @ w_glu.astype(f32) + b_glu.astype(f32))
    return out.astype(u.dtype)


def conformer_conv(a, g, conv_w, conv_b, ln_g, ln_b, w_pw2, b_pw2):
    u = a * jax.nn.sigmoid(g)
    y = lax.conv_general_dilated(
        u, conv_w[:, None, :], window_strides=(1,),
        padding=((CONV_WIDTH - 1, 0),),
        dimension_numbers=('NWC', 'WIO', 'NWC'),
        feature_group_count=D_CONV) + conv_b
    y = jax.nn.silu(layer_norm(y, ln_g, ln_b))
    return y @ w_pw2 + b_pw2


def setup_inputs(seed: int = 0) -> dict:
    key = jax.random.key(seed)
    ks = jax.random.split(key, 32)
    f32 = jnp.float32
    L = DEPTH

    def nrm(k, shape, scale):
        return jax.random.normal(k, shape, f32) * scale

    def gain(k, shape):
        return 1.0 + 0.02 * jax.random.normal(k, shape, f32)

    n_idx = jnp.arange(SSM_STATE, dtype=f32)
    return {
        "x": nrm(ks[0], (BATCH, SEQ, D_MODEL), 1.0),
        "norm_mix_g": gain(ks[1], (L, D_MODEL)),
        "w_in": nrm(ks[2], (L, D_MODEL, D_IN), D_MODEL ** -0.5),
        "lambda_re": -0.5 + 0.01 * jax.random.normal(ks[3], (L, SSM_GROUPS, SSM_STATE), f32),
        "lambda_im": math.pi * n_idx + 0.01 * jax.random.normal(ks[4], (L, SSM_GROUPS, SSM_STATE), f32),
        "log_dt": jax.random.uniform(ks[5], (L, SSM_GROUPS), f32, math.log(1e-3), math.log(1e-1)),
        "b_re": nrm(ks[6], (L, SSM_GROUPS, SSM_STATE, SSM_GROUP), (2 * SSM_GROUP) ** -0.5),
        "b_im": nrm(ks[7], (L, SSM_GROUPS, SSM_STATE, SSM_GROUP), (2 * SSM_GROUP) ** -0.5),
        "c_re": nrm(ks[8], (L, SSM_GROUPS, SSM_GROUP, SSM_STATE), (2 * SSM_STATE) ** -0.5),
        "c_im": nrm(ks[9], (L, SSM_GROUPS, SSM_GROUP, SSM_STATE), (2 * SSM_STATE) ** -0.5),
        "d_skip": nrm(ks[10], (L, SSM_GROUPS, SSM_GROUP), 1.0),
        "w_ssm_glu": nrm(ks[11], (L, D_SSM, D_SSM), D_SSM ** -0.5),
        "b_ssm_glu": nrm(ks[12], (L, D_SSM), 0.01),
        "conv_w": nrm(ks[13], (L, CONV_WIDTH, D_CONV), CONV_WIDTH ** -0.5),
        "conv_b": nrm(ks[14], (L, D_CONV), 0.01),
        "conv_ln_g": gain(ks[15], (L, D_CONV)),
        "conv_ln_b": nrm(ks[16], (L, D_CONV), 0.01),
        "w_conv_pw2": nrm(ks[17], (L, D_CONV, D_CONV), D_CONV ** -0.5),
        "b_conv_pw2": nrm(ks[18], (L, D_CONV), 0.01),
        "g_attn_out": gain(ks[19], (L, D_ATTN)),
        "g_ssm_out": gain(ks[20], (L, D_SSM)),
        "g_conv_out": gain(ks[21], (L, D_CONV)),
        "w_out": nrm(ks[22], (L, D_MIX, D_MODEL), D_MIX ** -0.5),
        "norm_ffn_g": gain(ks[23], (L, D_MODEL)),
        "w_gate_up": nrm(ks[24], (L, D_MODEL, 2 * D_FF), D_MODEL ** -0.5),
        "w_down": nrm(ks[25], (L, D_FF, D_MODEL), D_FF ** -0.5),
        "final_norm_g": gain(ks[26], (D_MODEL,)),
    }


def reference(x, norm_mix_g, w_in, lambda_re, lambda_im, log_dt, b_re, b_im, c_re, c_im,
              d_skip, w_ssm_glu, b_ssm_glu, conv_w, conv_b, conv_ln_g, conv_ln_b,
              w_conv_pw2, b_conv_pw2, g_attn_out, g_ssm_out, g_conv_out, w_out,
              norm_ffn_g, w_gate_up, w_down, final_norm_g):
    bsz, seq, _ = x.shape
    cos, sin = rope_tables(seq)
    h = x
    for l in range(DEPTH):
        hn = rms_norm(h, norm_mix_g[l])
        proj = hn @ w_in[l]
        q, k, v, u_ssm, a_conv, g_conv = jnp.split(proj, SPLITS, axis=-1)
        qh = apply_partial_rope(split_heads(q, bsz, seq), cos, sin)
        kh = apply_partial_rope(split_heads(k, bsz, seq), cos, sin)
        vh = split_heads(v, bsz, seq)
        o_attn = moba_attention(qh, kh, vh).transpose(0, 2, 1, 3).reshape(bsz, seq, D_ATTN)
        o_ssm = s5_mixer(u_ssm, lambda_re[l], lambda_im[l], log_dt[l], b_re[l], b_im[l],
                         c_re[l], c_im[l], d_skip[l], w_ssm_glu[l], b_ssm_glu[l])
        o_conv = conformer_conv(a_conv, g_conv, conv_w[l], conv_b[l], conv_ln_g[l],
                                conv_ln_b[l], w_conv_pw2[l], b_conv_pw2[l])
        mixed = jnp.concatenate([rms_norm(o_attn, g_attn_out[l]),
                                 rms_norm(o_ssm, g_ssm_out[l]),
                                 rms_norm(o_conv, g_conv_out[l])], axis=-1)
        h = h + mixed @ w_out[l]
        hn = rms_norm(h, norm_ffn_g[l])
        gate, up = jnp.split(hn @ w_gate_up[l], 2, axis=-1)
        h = h + (jax.nn.silu(gate) * up) @ w_down[l]
    return rms_norm(h, final_norm_g)
```

```cpp
#include <hip/hip_runtime.h>
#include <cstdio>
#include <cstdint>
namespace pg8 {
#define PG8_LAS __attribute__((address_space(3)))
typedef unsigned short bf16_t;
typedef short bf16x8 __attribute__((ext_vector_type(8)));
typedef float f32x4 __attribute__((ext_vector_type(4)));
typedef unsigned u32x4 __attribute__((ext_vector_type(4)));
constexpr int BM = 256, BK = 64, HALF = 128, HTB = HALF * BK * 2  , STAGE_BYTES = 8 * HTB, NXCD = 8, WGM = 8;

__host__ __device__ __forceinline__ int lds_byte(int r, int c) { const int st = (r >> 4) * 2 + (c >> 5), rr = r & 15, cc = c & 31, ob = rr * 64 + cc * 2; return st * 1024 + (ob ^ (((ob >> 9) & 1) << 5)); }
__host__ __device__ __forceinline__ void stage_rc(int b, int& R, int& C) { const int st = b / 1024, sb = b % 1024, swz = sb ^ (((sb >> 9) & 1) << 5); R = (st >> 1) * 16 + swz / 64; C = (st & 1) * 32 + (swz % 64) / 2; }
__host__ __device__ __forceinline__ int perm32(int rho) { const int n = rho >> 4, i = rho & 15; return 8 * (i >> 2) + 4 * n + (i & 3); }

struct Unit { int pm, pn; };
struct Gemm { const bf16_t* A; const bf16_t* Bt; int M, N, K; };

struct StaticOrder {
    int nM, nN, nwg, G, c;
    __host__ __device__ void init(int M, int N, int G_, int c_) { nM = M / BM; nN = N / BM; nwg = nM * nN; G = G_; c = c_; }
    __host__ __device__ bool next(int i, Unit& u) const {
        const long L = (long)i * G + c; if (L >= nwg) return false;
        int wgid = (int)L; { const int q = nwg / NXCD, r = nwg % NXCD, xcd = wgid % NXCD, off = wgid / NXCD; wgid = (xcd < r ? xcd * (q + 1) : r * (q + 1) + (xcd - r) * q) + off; }
        const int nig = WGM * nN, gid = wgid / nig, fm = gid * WGM, gsz = (nM - fm) < WGM ? (nM - fm) : WGM;
        u.pm = fm + ((wgid % nig) % gsz); u.pn = (wgid % nig) / gsz; return true;
    }
    __device__ __forceinline__ void a_ready(const Unit&) const {}
    __device__ __forceinline__ void done(const Unit&) const {}
};

__device__ __forceinline__ unsigned cvt_pk_bf16(float lo, float hi) { unsigned r; asm volatile("v_cvt_pk_bf16_f32 %0, %1, %2" : "=v"(r) : "v"(lo), "v"(hi)); return r; }
typedef float f32x2 __attribute__((ext_vector_type(2)));
}

namespace mdl {
constexpr int BATCH = 8, SEQ = 4096, DM = 1024, M = BATCH * SEQ, DEPTH = 2;
constexpr int D_ATTN = 512, NHEAD = 8, HD = 64, D_SSM = 256, D_CONV = 256, NGRP = 16, GCH = 16, NST = 64, CWID = 31;
constexpr int D_IN = 2304, D_FF = 2816, D_GU = 5632, NBLK = SEQ / 256;
constexpr float RMS_EPS = 1e-6f, LN_EPS = 1e-5f;
constexpr float C2 = 0.125f * 1.4426950408889634f;
}

namespace pg8 {
typedef unsigned u32x2 __attribute__((ext_vector_type(2)));
__device__ __forceinline__ float row_rstd16(const float* ssq, int row, float inv_n, float eps) {
    const f32x4* p = (const f32x4*)(ssq + (size_t)row * 16); const f32x4 a = p[0], b = p[1], c = p[2], d = p[3];
    const float s = ((a[0] + a[1]) + (a[2] + a[3])) + ((b[0] + b[1]) + (b[2] + b[3])) + ((c[0] + c[1]) + (c[2] + c[3])) + ((d[0] + d[1]) + (d[2] + d[3]));
    return 1.0f / sqrtf(s * inv_n + eps);
}
__device__ __forceinline__ float sigmoidf_(float x) { return 1.0f / (1.0f + __expf(-x)); }

struct EpiInProj {
    static constexpr bool PERM = true, AFTER_DRAIN = false;
    const float* ssq; const float* rope; bf16_t *Qb, *Kb, *Vb, *Us, *Uc; float* Qf; float* kmp;
    __device__ __forceinline__ void operator()(const f32x4 (&acc)[2][2][4][2], const Unit& u, int wr, int wc, int fr, int fq) const {
        asm volatile("" : "+v"(fr), "+v"(fq));
        const int pn = u.pn, rowb = u.pm * BM + wr * 64 + fr, lcol = wc * 32 + fq * 8;
        const bool isq = pn < 2, isk = (pn == 2 || pn == 3);
        if (isq || isk) {
            const bool rotw = (wc & 1) == 0;
            const bool rot = rotw && fq < 2; const float sgn = fq == 0 ? -1.f : 1.f;
            f32x4 cs[2][2];
#pragma unroll
            for (int bj = 0; bj < 2; ++bj)
#pragma unroll
                for (int n = 0; n < 2; ++n) cs[bj][n] = (f32x4){0.f, 0.f, 0.f, 0.f};
            bf16_t* O = isq ? Qb : Kb; const int ct = isq ? pn : pn - 2;
#pragma unroll
            for (int ai = 0; ai < 2; ++ai)
#pragma unroll
                for (int m = 0; m < 4; ++m) {
                    const int row = rowb + ai * HALF + m * 16; const float rs = row_rstd16(ssq, row, 1.0f / 1024.0f, mdl::RMS_EPS);
                    f32x4 v[2][2];
#pragma unroll
                    for (int bj = 0; bj < 2; ++bj)
#pragma unroll
                        for (int n = 0; n < 2; ++n) v[bj][n] = acc[ai][bj][m][n] * rs;
                    if (rotw) {
                        const f32x4* rp = (const f32x4*)(rope + (size_t)(row & (mdl::SEQ - 1)) * 16);
                        const f32x4 r0 = rp[0], r1 = rp[1], r2 = rp[2], r3 = rp[3];
                        const float cc[2][4] = {{r0[0], r0[2], r1[0], r1[2]}, {r2[0], r2[2], r3[0], r3[2]}}, ss[2][4] = {{r0[1], r0[3], r1[1], r1[3]}, {r2[1], r2[3], r3[1], r3[3]}};
#pragma unroll
                        for (int bj = 0; bj < 2; ++bj)
#pragma unroll
                            for (int n = 0; n < 2; ++n)
#pragma unroll
                                for (int i = 0; i < 4; ++i) { const float x = v[bj][n][i], p = __shfl_xor(x, 16); if (rot) v[bj][n][i] = x * cc[n][i] + sgn * p * ss[n][i]; }
                    }
#pragma unroll
                    for (int bj = 0; bj < 2; ++bj) {
                        const size_t off = (size_t)row * 512 + ct * 256 + bj * HALF + lcol;
                        const float sc = isq ? mdl::C2 : 1.0f;
                        u32x4 w; w.x = cvt_pk_bf16(v[bj][0][0] * sc, v[bj][0][1] * sc); w.y = cvt_pk_bf16(v[bj][0][2] * sc, v[bj][0][3] * sc); w.z = cvt_pk_bf16(v[bj][1][0] * sc, v[bj][1][1] * sc); w.w = cvt_pk_bf16(v[bj][1][2] * sc, v[bj][1][3] * sc);
                        *(u32x4*)(O + off) = w;
                        if (isq) { *(f32x4*)(Qf + off) = v[bj][0]; *(f32x4*)(Qf + off + 4) = v[bj][1]; }
                        else { cs[bj][0] += v[bj][0]; cs[bj][1] += v[bj][1]; }
                    }
                }
            if (isk) {
#pragma unroll
                for (int bj = 0; bj < 2; ++bj)
#pragma unroll
                    for (int n = 0; n < 2; ++n)
#pragma unroll
                        for (int i = 0; i < 4; ++i) { float s = cs[bj][n][i]; s += __shfl_xor(s, 1); s += __shfl_xor(s, 2); s += __shfl_xor(s, 4); s += __shfl_xor(s, 8); cs[bj][n][i] = s; }
                if (fr == 0) {
                    float* kp = kmp + ((size_t)(wr * mdl::BATCH * mdl::NBLK + u.pm) * 512) + ct * 256 + lcol;
#pragma unroll
                    for (int bj = 0; bj < 2; ++bj) { *(f32x4*)(kp + bj * HALF) = cs[bj][0]; *(f32x4*)(kp + bj * HALF + 4) = cs[bj][1]; }
                }
            }
        } else if (pn < 7) {
            bf16_t* O = pn == 6 ? Us : Vb; const int ld = pn == 6 ? 256 : 512, ct = pn == 6 ? 0 : pn - 4;
#pragma unroll
            for (int ai = 0; ai < 2; ++ai)
#pragma unroll
                for (int m = 0; m < 4; ++m) {
                    const int row = rowb + ai * HALF + m * 16; const float rs = row_rstd16(ssq, row, 1.0f / 1024.0f, mdl::RMS_EPS);
#pragma unroll
                    for (int bj = 0; bj < 2; ++bj) { const f32x4 v0 = acc[ai][bj][m][0] * rs, v1 = acc[ai][bj][m][1] * rs;
                        u32x4 w; w.x = cvt_pk_bf16(v0[0], v0[1]); w.y = cvt_pk_bf16(v0[2], v0[3]); w.z = cvt_pk_bf16(v1[0], v1[1]); w.w = cvt_pk_bf16(v1[2], v1[3]);
                        *(u32x4*)(O + (size_t)row * ld + ct * 256 + bj * HALF + lcol) = w; }
                }
        } else {
            const int ct = pn - 7;
#pragma unroll
            for (int ai = 0; ai < 2; ++ai)
#pragma unroll
                for (int m = 0; m < 4; ++m) {
                    const int row = rowb + ai * HALF + m * 16; const float rs = row_rstd16(ssq, row, 1.0f / 1024.0f, mdl::RMS_EPS);
                    float o[8];
#pragma unroll
                    for (int n = 0; n < 2; ++n)
#pragma unroll
                        for (int i = 0; i < 4; ++i) { const float a = acc[ai][0][m][n][i] * rs, g = acc[ai][1][m][n][i] * rs; o[n * 4 + i] = a * sigmoidf_(g); }
                    u32x4 w; w.x = cvt_pk_bf16(o[0], o[1]); w.y = cvt_pk_bf16(o[2], o[3]); w.z = cvt_pk_bf16(o[4], o[5]); w.w = cvt_pk_bf16(o[6], o[7]);
                    *(u32x4*)(Uc + (size_t)row * 256 + ct * HALF + lcol) = w;
                }
        }
    }
};

struct EpiResid {
    static constexpr bool PERM = false, AFTER_DRAIN = false;
    const float* base; float* out; bf16_t* hb; float* ssq;
    __device__ __forceinline__ void operator()(const f32x4 (&acc)[2][2][4][2], const Unit& u, int wr, int wc, int fr, int fq) const {
        asm volatile("" : "+v"(fr), "+v"(fq));
        const int col0 = u.pn * BM + wc * 32 + 4 * fq;
#pragma unroll
        for (int ai = 0; ai < 2; ++ai)
#pragma unroll
            for (int m = 0; m < 4; ++m) {
                const int row = u.pm * BM + ai * HALF + wr * 64 + m * 16 + fr; const size_t off = (size_t)row * mdl::DM + col0; float s = 0.f;
#pragma unroll
                for (int bj = 0; bj < 2; ++bj)
#pragma unroll
                    for (int n = 0; n < 2; ++n) { const f32x4 o = *(const f32x4*)(base + off + bj * HALF + n * 16) + acc[ai][bj][m][n];
                        *(f32x4*)(out + off + bj * HALF + n * 16) = o; s += (o[0] * o[0] + o[1] * o[1]) + (o[2] * o[2] + o[3] * o[3]);
                        u32x2 w; w.x = cvt_pk_bf16(o[0], o[1]); w.y = cvt_pk_bf16(o[2], o[3]); *(u32x2*)(hb + off + bj * HALF + n * 16) = w; }
                s += __shfl_xor(s, 16); s += __shfl_xor(s, 32);
                if (fq == 0) ssq[(size_t)row * 16 + u.pn * 4 + wc] = s;
                if (m & 1) asm volatile("" ::: "memory");
            }
    }
};

struct EpiSwiGlu {
    static constexpr bool PERM = true, AFTER_DRAIN = false;
    const float* ssq; bf16_t* act;
    __device__ __forceinline__ void operator()(const f32x4 (&acc)[2][2][4][2], const Unit& u, int wr, int wc, int fr, int fq) const {
        asm volatile("" : "+v"(fr), "+v"(fq));
        const int col0 = u.pn * HALF + wc * 32 + fq * 8;
#pragma unroll
        for (int ai = 0; ai < 2; ++ai)
#pragma unroll
            for (int m = 0; m < 4; ++m) {
                const int row = u.pm * BM + ai * HALF + wr * 64 + m * 16 + fr; const float rs = row_rstd16(ssq, row, 1.0f / 1024.0f, mdl::RMS_EPS);
                float o[8];
#pragma unroll
                for (int n = 0; n < 2; ++n)
#pragma unroll
                    for (int i = 0; i < 4; ++i) { const float g = acc[ai][0][m][n][i] * rs, up = acc[ai][1][m][n][i] * rs; o[n * 4 + i] = g * sigmoidf_(g) * up; }
                u32x4 w; w.x = cvt_pk_bf16(o[0], o[1]); w.y = cvt_pk_bf16(o[2], o[3]); w.z = cvt_pk_bf16(o[4], o[5]); w.w = cvt_pk_bf16(o[6], o[7]);
                *(u32x4*)(act + (size_t)row * mdl::D_FF + col0) = w;
            }
    }
};

template <int MODE> struct EpiRowNorm {
    static constexpr bool PERM = true, AFTER_DRAIN = true;
    const bf16_t* z; const float* bias; bf16_t* out; int ocol;
    __device__ __forceinline__ void fused(f32x4 (&acc)[2][2][4][2], const Unit& u, int wr, int wc, int fr, int fq, PG8_LAS unsigned char* lds, int wid, int lane) const {
        asm volatile("" : "+v"(fr), "+v"(fq));
        PG8_LAS float* P = (PG8_LAS float*)lds;
        const int lcol = wc * 32 + fq * 8;
        f32x4 bv[2][2];
#pragma unroll
        for (int bj = 0; bj < 2; ++bj)
#pragma unroll
            for (int n = 0; n < 2; ++n) bv[bj][n] = *(const f32x4*)(bias + bj * HALF + lcol + 4 * n);
#pragma unroll
        for (int ai = 0; ai < 2; ++ai)
#pragma unroll
            for (int m = 0; m < 4; ++m) {
                const int lrow = ai * HALF + wr * 64 + m * 16 + fr, row = u.pm * BM + lrow; float s = 0.f;
#pragma unroll
                for (int bj = 0; bj < 2; ++bj) {
                    f32x4 v0 = acc[ai][bj][m][0] + bv[bj][0], v1 = acc[ai][bj][m][1] + bv[bj][1];
                    if (MODE == 0) {
                        const u32x4 zz = *(const u32x4*)(z + (size_t)row * 256 + bj * HALF + lcol);
                        const float z0 = __uint_as_float(zz.x << 16), z1 = __uint_as_float(zz.x & 0xffff0000u), z2 = __uint_as_float(zz.y << 16), z3 = __uint_as_float(zz.y & 0xffff0000u);
                        const float z4 = __uint_as_float(zz.z << 16), z5 = __uint_as_float(zz.z & 0xffff0000u), z6 = __uint_as_float(zz.w << 16), z7 = __uint_as_float(zz.w & 0xffff0000u);
                        v0 = (f32x4){z0 * sigmoidf_(v0[0]), z1 * sigmoidf_(v0[1]), z2 * sigmoidf_(v0[2]), z3 * sigmoidf_(v0[3])};
                        v1 = (f32x4){z4 * sigmoidf_(v1[0]), z5 * sigmoidf_(v1[1]), z6 * sigmoidf_(v1[2]), z7 * sigmoidf_(v1[3])};
                    }
                    acc[ai][bj][m][0] = v0; acc[ai][bj][m][1] = v1;
                    s += (v0[0] * v0[0] + v0[1] * v0[1]) + (v0[2] * v0[2] + v0[3] * v0[3]) + (v1[0] * v1[0] + v1[1] * v1[1]) + (v1[2] * v1[2] + v1[3] * v1[3]);
                }
                s += __shfl_xor(s, 16); s += __shfl_xor(s, 32);
                if (fq == 0) P[lrow * 4 + wc] = s;
                asm volatile("" ::: "memory");
            }
        asm volatile("s_waitcnt lgkmcnt(0)" ::: "memory"); __builtin_amdgcn_s_barrier(); asm volatile("" ::: "memory");
#pragma unroll
        for (int ai = 0; ai < 2; ++ai)
#pragma unroll
            for (int m = 0; m < 4; ++m) {
                const int lrow = ai * HALF + wr * 64 + m * 16 + fr, row = u.pm * BM + lrow;
                const f32x4 pp = *(const PG8_LAS f32x4*)(P + lrow * 4); const float rs = 1.0f / sqrtf(((pp[0] + pp[1]) + (pp[2] + pp[3])) * (1.0f / 256.0f) + mdl::RMS_EPS);
#pragma unroll
                for (int bj = 0; bj < 2; ++bj) { const f32x4 v0 = acc[ai][bj][m][0] * rs, v1 = acc[ai][bj][m][1] * rs;
                    u32x4 w; w.x = cvt_pk_bf16(v0[0], v0[1]); w.y = cvt_pk_bf16(v0[2], v0[3]); w.z = cvt_pk_bf16(v1[0], v1[1]); w.w = cvt_pk_bf16(v1[2], v1[3]);
                    *(u32x4*)(out + (size_t)row * mdl::DM + ocol + bj * HALF + lcol) = w; }
                asm volatile("" ::: "memory");
            }
        asm volatile("s_waitcnt lgkmcnt(0)" ::: "memory"); __builtin_amdgcn_s_barrier(); asm volatile("" ::: "memory");
    }
};
struct OneUnit {
    int pm; bool on;
    __device__ __forceinline__ bool next(int i, Unit& u) const { if (i > 0 || !on) return false; u.pm = pm; u.pn = 0; return true; }
    __device__ __forceinline__ void a_ready(const Unit&) const {}
    __device__ __forceinline__ void done(const Unit&) const {}
};
}
namespace pg8 {
template <class Epi, class Sched, bool ALIGN_EPI = false, bool SP2 = false>
__device__ __forceinline__ void gemm_phase(PG8_LAS unsigned char* lds, const Gemm g, const Sched& S, const Epi& E) {
    int tid_ = threadIdx.x; asm volatile("" : "+v"(tid_));
    const int tid = tid_, wid = __builtin_amdgcn_readfirstlane(tid >> 6), lane = tid & 63, wr = wid >> 2, wc = wid & 3, fr = lane & 15, fq = lane >> 4;
    const int K = g.K, nt = K / BK;
    unsigned voffA[2], voffB[2];
#pragma unroll
    for (int i = 0; i < 2; ++i) { int R, C; stage_rc(tid * 16 + i * 8192, R, C); const int Rb = Epi::PERM ? ((R & ~31) + perm32(R & 31)) : R;
        voffA[i] = (unsigned)(R * K + C) * 2u; voffB[i] = (unsigned)(Rb * K + C) * 2u; }
    const size_t kstep = (size_t)(BK * 2);
    const size_t hstep = (size_t)HALF * K * 2;
    const size_t tstep = 2 * hstep;
    const unsigned ldsw = (unsigned)wid * 1024u;
    const int aoff = lds_byte(wr * 64 + fr, fq * 8), boff = lds_byte(wc * 32 + fr, fq * 8);
#define PG8_SA(b, h) (((b) * 2 + (h)) * HTB)
#define PG8_SB(b, h) ((4 + (b) * 2 + (h)) * HTB)
#define PG8_STAGE(bufoff, gbase, voff) do { _Pragma("unroll") for (int _i = 0; _i < 2; ++_i) \
        __builtin_amdgcn_global_load_lds((const unsigned*)((const char*)(gbase) + (voff)[_i]), (PG8_LAS unsigned*)(lds + (bufoff) + ldsw + _i * 8192), 16, 0, 0); } while (0)
#define PG8_LDA(dst, b, h) do { _Pragma("unroll") for (int m = 0; m < 4; ++m) _Pragma("unroll") for (int k = 0; k < 2; ++k) dst[m][k] = *(const PG8_LAS bf16x8*)(lds + PG8_SA(b, h) + aoff + m * 2048 + k * 1024); } while (0)
#define PG8_LDB(dst, b, h) do { _Pragma("unroll") for (int n = 0; n < 2; ++n) _Pragma("unroll") for (int k = 0; k < 2; ++k) dst[n][k] = *(const PG8_LAS bf16x8*)(lds + PG8_SB(b, h) + boff + n * 2048 + k * 1024); } while (0)
#define PG8_MMA(ai, bj, At, Bt) do { __builtin_amdgcn_s_setprio(1); _Pragma("unroll") for (int m = 0; m < 4; ++m) _Pragma("unroll") for (int n = 0; n < 2; ++n) _Pragma("unroll") for (int k = 0; k < 2; ++k) \
        acc[ai][bj][m][n] = __builtin_amdgcn_mfma_f32_16x16x32_bf16(Bt[n][k], At[m][k], acc[ai][bj][m][n], 0, 0, 0); __builtin_amdgcn_s_setprio(0); } while (0)
#define PG8_WAIT_V(n) asm volatile("s_waitcnt vmcnt(" #n ")" ::: "memory")
#define PG8_WAIT_L(n) asm volatile("s_waitcnt lgkmcnt(" #n ")" ::: "memory")
#define PG8_BAR __builtin_amdgcn_s_barrier()
#define PG8_SCHED __builtin_amdgcn_sched_barrier(0)
    Unit cur, nxt; int ui = 0;
    if (!S.next(0, cur)) return;
    f32x4 acc[2][2][4][2];
#pragma unroll
    for (int a = 0; a < 2; ++a)
#pragma unroll
        for (int b = 0; b < 2; ++b)
#pragma unroll
            for (int m = 0; m < 4; ++m)
#pragma unroll
                for (int n = 0; n < 2; ++n) acc[a][b][m][n] = (f32x4){0.f, 0.f, 0.f, 0.f};
    bf16x8 At[4][2], B0[2][2], B1[2][2];
    const char* cA = (const char*)g.A + (size_t)cur.pm * tstep; const char* cB = (const char*)g.Bt + (size_t)cur.pn * tstep;
    S.a_ready(cur);
    if constexpr (SP2) {
        PG8_STAGE(PG8_SB(0, 0), cB, voffB); PG8_STAGE(PG8_SB(0, 1), cB + hstep, voffB); PG8_STAGE(PG8_SA(0, 0), cA, voffA); PG8_STAGE(PG8_SA(0, 1), cA + hstep, voffA);
        if (wr == 1) PG8_BAR;
        PG8_WAIT_V(2); PG8_BAR;
        PG8_STAGE(PG8_SB(1, 0), cB + kstep, voffB); PG8_STAGE(PG8_SA(1, 0), cA + kstep, voffA); PG8_STAGE(PG8_SB(1, 1), cB + hstep + kstep, voffB);
        PG8_WAIT_V(6); PG8_BAR;
    } else {
        PG8_STAGE(PG8_SB(0, 0), cB, voffB); PG8_STAGE(PG8_SA(0, 0), cA, voffA); PG8_STAGE(PG8_SB(0, 1), cB + hstep, voffB); PG8_STAGE(PG8_SA(0, 1), cA + hstep, voffA);
        if (wr == 1) PG8_BAR;
        PG8_WAIT_V(4); PG8_BAR;
        PG8_STAGE(PG8_SB(1, 0), cB + kstep, voffB); PG8_STAGE(PG8_SA(1, 0), cA + kstep, voffA); PG8_STAGE(PG8_SB(1, 1), cB + hstep + kstep, voffB);
        PG8_WAIT_V(6); PG8_BAR;
    }
    for (;;) {
        const bool has_next = S.next(ui + 1, nxt);
        const char* nA = has_next ? (const char*)g.A + (size_t)nxt.pm * tstep : cA; const char* nB = has_next ? (const char*)g.Bt + (size_t)nxt.pn * tstep : cB;
        for (int t = 0; t < nt; t += 2) {
            const bool last = (t == nt - 2);
            const char* a1 = cA + (size_t)(t + 1) * kstep;
            const char* a2 = last ? nA : cA + (size_t)(t + 2) * kstep; const char* b2 = last ? nB : cB + (size_t)(t + 2) * kstep;
            const char* a3 = a2 + kstep; const char* b3 = b2 + kstep;
            if (last && has_next) S.a_ready(nxt);
            if constexpr (SP2) {
            PG8_LDB(B0, 0, 0); PG8_LDB(B1, 0, 1); PG8_SCHED; PG8_LDA(At, 0, 0); PG8_STAGE(PG8_SA(1, 1), a1 + hstep, voffA);
            PG8_WAIT_V(8); PG8_WAIT_L(0); PG8_BAR; PG8_MMA(0, 0, At, B0); PG8_MMA(0, 1, At, B1); PG8_BAR; PG8_SCHED;
            PG8_LDA(At, 0, 1); PG8_STAGE(PG8_SB(0, 0), b2, voffB); PG8_STAGE(PG8_SB(0, 1), b2 + hstep, voffB); PG8_STAGE(PG8_SA(0, 0), a2, voffA);
            PG8_WAIT_V(8); PG8_WAIT_L(0); PG8_BAR; PG8_MMA(1, 0, At, B0); PG8_MMA(1, 1, At, B1); PG8_BAR; PG8_SCHED;
            PG8_LDB(B0, 1, 0); PG8_LDB(B1, 1, 1); PG8_SCHED; PG8_LDA(At, 1, 0); PG8_STAGE(PG8_SA(0, 1), a2 + hstep, voffA);
            PG8_WAIT_V(8); PG8_WAIT_L(0); PG8_BAR; PG8_MMA(0, 0, At, B0); PG8_MMA(0, 1, At, B1); PG8_BAR; PG8_SCHED;
            PG8_LDA(At, 1, 1); PG8_STAGE(PG8_SB(1, 0), b3, voffB); PG8_STAGE(PG8_SB(1, 1), b3 + hstep, voffB); PG8_STAGE(PG8_SA(1, 0), a3, voffA);
            PG8_WAIT_V(8); PG8_WAIT_L(0); PG8_BAR; PG8_MMA(1, 0, At, B0); PG8_MMA(1, 1, At, B1); PG8_BAR; PG8_SCHED;
            } else {
            PG8_LDB(B0, 0, 0); PG8_SCHED; PG8_LDA(At, 0, 0); PG8_STAGE(PG8_SA(1, 1), a1 + hstep, voffA);
            PG8_WAIT_L(8); PG8_BAR; PG8_WAIT_L(0); PG8_MMA(0, 0, At, B0); PG8_BAR; PG8_SCHED;
            PG8_LDB(B1, 0, 1); PG8_STAGE(PG8_SB(0, 0), b2, voffB);
            PG8_BAR; PG8_WAIT_L(0); PG8_MMA(0, 1, At, B1); PG8_BAR;
            PG8_LDA(At, 0, 1); PG8_STAGE(PG8_SA(0, 0), a2, voffA);
            PG8_BAR; PG8_WAIT_L(0); PG8_MMA(1, 0, At, B0); PG8_BAR; PG8_SCHED;
            PG8_STAGE(PG8_SB(0, 1), b2 + hstep, voffB);
            PG8_WAIT_V(6); PG8_BAR; PG8_MMA(1, 1, At, B1); PG8_BAR;
            PG8_LDB(B0, 1, 0); PG8_SCHED; PG8_LDA(At, 1, 0); PG8_STAGE(PG8_SA(0, 1), a2 + hstep, voffA);
            PG8_WAIT_L(8); PG8_BAR; PG8_WAIT_L(0); PG8_MMA(0, 0, At, B0); PG8_BAR; PG8_SCHED;
            PG8_LDB(B1, 1, 1); PG8_STAGE(PG8_SB(1, 0), b3, voffB);
            PG8_BAR; PG8_WAIT_L(0); PG8_MMA(0, 1, At, B1); PG8_BAR;
            PG8_LDA(At, 1, 1); PG8_STAGE(PG8_SA(1, 0), a3, voffA);
            PG8_BAR; PG8_WAIT_L(0); PG8_MMA(1, 0, At, B0); PG8_BAR; PG8_SCHED;
            PG8_STAGE(PG8_SB(1, 1), b3 + hstep, voffB);
            PG8_WAIT_V(6); PG8_BAR; PG8_MMA(1, 1, At, B1); PG8_BAR;
            }
        }
        if constexpr (ALIGN_EPI) { if (wr == 0) PG8_BAR; }
        if constexpr (!Epi::AFTER_DRAIN) { E(acc, cur, wr, wc, fr, fq); S.done(cur); }
        if (!has_next) break;
#pragma unroll
        for (int a = 0; a < 2; ++a)
#pragma unroll
            for (int b = 0; b < 2; ++b)
#pragma unroll
                for (int m = 0; m < 4; ++m)
#pragma unroll
                    for (int n = 0; n < 2; ++n) acc[a][b][m][n] = (f32x4){0.f, 0.f, 0.f, 0.f};
        cur = nxt; cA = nA; cB = nB; ++ui;
        if constexpr (ALIGN_EPI) { if (wr == 1) PG8_BAR; }
    }
    PG8_WAIT_V(0);
    if constexpr (!ALIGN_EPI) { if (wr == 0) PG8_BAR; }
    PG8_BAR;
    if constexpr (Epi::AFTER_DRAIN) { E.fused(acc, cur, wr, wc, fr, fq, lds, wid, lane); S.done(cur); }
#undef PG8_SA
#undef PG8_SB
#undef PG8_STAGE
#undef PG8_LDA
#undef PG8_LDB
#undef PG8_MMA
#undef PG8_WAIT_V
#undef PG8_WAIT_L
#undef PG8_BAR
#undef PG8_SCHED
}
}
#define GAS __attribute__((address_space(1)))
#define LAS __attribute__((address_space(3)))
typedef unsigned short bf16;
typedef unsigned v4u __attribute__((ext_vector_type(4)));
typedef float f32x4 __attribute__((ext_vector_type(4)));
typedef short bf16x8 __attribute__((ext_vector_type(8)));
typedef GAS unsigned gu32;
typedef GAS unsigned long long gu64;
#define RLX_AGENT __ATOMIC_RELAXED, __HIP_MEMORY_SCOPE_AGENT
#define LDS_WAIT() asm volatile("s_waitcnt lgkmcnt(0)" ::: "memory")
#define VM_WAIT() asm volatile("s_waitcnt vmcnt(0)" ::: "memory")
__device__ __forceinline__ unsigned long long rt() { return __builtin_amdgcn_s_memrealtime(); }
__device__ __forceinline__ unsigned f2bf(float f) { unsigned u = __builtin_bit_cast(unsigned, f); return (u + 0x7fffu + ((u >> 16) & 1u)) >> 16; }
__device__ __forceinline__ unsigned pk2(float lo, float hi) { return f2bf(lo) | (f2bf(hi) << 16); }

#define XB_TMO      128
#define XB_XCNT(j)  (256  + 64 * (j))
#define XB_XSUB(j)  (1280 + 64 * (j))
#define XB_XGEN(j)  (2304 + 64 * (j))
#define XB_TOP      3328
#define XB_TOPGEN   3392
#define XCD_BAR_WORDS 3456
#define XB_SPIN_CAP (1u << 18)

__device__ __forceinline__ unsigned xb_ld(unsigned* p)              { return __hip_atomic_load(p, __ATOMIC_RELAXED, __HIP_MEMORY_SCOPE_AGENT); }
__device__ __forceinline__ unsigned xb_add(unsigned* p, unsigned v) { return __hip_atomic_fetch_add(p, v, __ATOMIC_RELAXED, __HIP_MEMORY_SCOPE_AGENT); }
__device__ __forceinline__ unsigned xb_xcc_id() { return (unsigned)__builtin_amdgcn_s_getreg((3 << 11) | 20) & 0xFu; }
#define XB_SPIN(cond, bar) do { unsigned _sp = 0; while (cond) { __builtin_amdgcn_s_sleep(1); \
    if ((++_sp & 255u) == 0u) { if (xb_ld(&(bar)[XB_TMO])) break; if (_sp > XB_SPIN_CAP) { atomicAdd(&(bar)[XB_TMO], 1u); break; } } } } while (0)

struct XcdBarrier {
    unsigned* bar; unsigned x;
    volatile LAS unsigned* st;
};

__device__ __forceinline__ XcdBarrier xcd_barrier_post(unsigned* bar, volatile LAS unsigned* st) {
    XcdBarrier b; b.bar = bar; b.x = xb_xcc_id(); b.st = st;
    if (threadIdx.x == 0) (void)xb_add(&bar[XB_XCNT(b.x)], 1u);
    return b;
}
__device__ __forceinline__ void xcd_barrier_complete(unsigned* bar, unsigned x, unsigned& nloc, unsigned& nx) {
    const unsigned G = gridDim.x * gridDim.y * gridDim.z;
    unsigned sum, cnt, mine, sp = 0u;
    for (;;) {
        sum = 0u; cnt = 0u; mine = 0u;
#pragma unroll
        for (unsigned j = 0; j < 16; ++j) { const unsigned c = xb_ld(&bar[XB_XCNT(j)]); sum += c; cnt += (c > 0u) ? 1u : 0u; mine = (j == x) ? c : mine; }
        if (sum == G) break;
        __builtin_amdgcn_s_sleep(1);
        if ((++sp & 255u) == 0u) { if (xb_ld(&bar[XB_TMO])) break; if (sp > XB_SPIN_CAP) { atomicAdd(&bar[XB_TMO], 1u); break; } }
    }
    nloc = mine > 0u ? mine : 1u; nx = cnt > 0u ? cnt : 1u;
}

__device__ __forceinline__ void xcd_barrier(const XcdBarrier& b) {
    asm volatile("s_waitcnt vmcnt(0)" ::: "memory");
    __syncthreads();
    if (threadIdx.x == 0) {
        unsigned* bar = b.bar;
        __builtin_amdgcn_s_waitcnt(0);
        unsigned nloc = b.st[0], nx = b.st[1];
        if (nloc == 0u) { xcd_barrier_complete(bar, b.x, nloc, nx); b.st[0] = nloc; b.st[1] = nx; }
        const unsigned old = xb_add(&bar[XB_XSUB(b.x)], 1u);
        const unsigned gen = old / nloc;
        if (old + 1u == (gen + 1u) * nloc) {
            __builtin_amdgcn_fence(__ATOMIC_RELEASE, "agent");
            asm volatile("s_waitcnt vmcnt(0)" ::: "memory");
            const unsigned og = xb_add(&bar[XB_TOP], 1u);
            const unsigned tg = og / nx;
            if (og + 1u == (tg + 1u) * nx) xb_add(&bar[XB_TOPGEN], 1u);
            else XB_SPIN(xb_ld(&bar[XB_TOPGEN]) == tg, bar);
            __builtin_amdgcn_fence(__ATOMIC_ACQUIRE, "agent");
            xb_add(&bar[XB_XGEN(b.x)], 1u);
            asm volatile("s_waitcnt vmcnt(0)" ::: "memory");
        } else {
            XB_SPIN(xb_ld(&bar[XB_XGEN(b.x)]) == gen, bar);
            __builtin_amdgcn_fence(__ATOMIC_ACQUIRE, "agent");
            asm volatile("s_waitcnt vmcnt(0)" ::: "memory");
        }
    }
    __syncthreads();
}

using namespace mdl;
constexpr int NWAVES = 8;
#ifndef MK_ONE_LAUNCH
#define MK_ONE_LAUNCH 1
#endif
constexpr int N_PHASES = 14;
constexpr size_t MiB = 1u << 20;
constexpr size_t WS_CTL = 0, CTL_ZERO_BYTES = 1 * MiB;
constexpr size_t WS_ROPE = 1 * MiB;
constexpr size_t WS_KMP = 1 * MiB + 512 * 1024;
constexpr size_t WS_SSQ = 2 * MiB;
constexpr size_t WS_W = 8 * MiB, W_LAYER = 24 * MiB;
constexpr size_t WO_IN = 0, WO_OUT = 5 * MiB, WO_GU = 7 * MiB, WO_DN = 18 * MiB, WO_GLU = 23 * MiB + 512 * 1024, WO_PW2 = 23 * MiB + 768 * 1024;
constexpr size_t WS_HB = 64 * MiB;
constexpr size_t WS_QB = 128 * MiB, WS_KB = 160 * MiB, WS_VB = 192 * MiB, WS_QF = 224 * MiB, WS_US = 288 * MiB, WS_UC = 304 * MiB, WS_Z = 320 * MiB, WS_YC = 336 * MiB, WS_MIX = 352 * MiB;
constexpr size_t WS_ACT = 128 * MiB;
constexpr size_t WS_END = 416 * MiB;
static_assert(WS_ACT + (size_t)M * D_FF * 2 <= WS_UC + 16 * MiB && WS_MIX + (size_t)M * DM * 2 <= WS_END, "d_ws map");
constexpr int CW_TMO = 0, CW_CODE = 1, CW_BAR = 4096;
constexpr int RING_OFF = 0, RING_BYTES = 131072;
constexpr int LDSCTL_OFF = RING_BYTES, MISC_OFF = LDSCTL_OFF + 320;
constexpr int LDS_BYTES = 147456;

struct Frame {
    LAS unsigned char* lds;
    volatile LAS unsigned* MISC;
    gu32* ctl;
    int tid, lane, wave;
    int vcu, G;
    unsigned char* ws;
};
__device__ __forceinline__ float wave_sum(float v) {
#pragma unroll
    for (int o = 1; o < 64; o <<= 1) v += __shfl_xor(v, o);
    return v;
}
__device__ __forceinline__ float wave_max(float v) {
#pragma unroll
    for (int o = 1; o < 64; o <<= 1) v = fmaxf(v, __shfl_xor(v, o));
    return v;
}
__device__ __forceinline__ float bf2f(bf16 v) { return __uint_as_float((unsigned)v << 16); }

__device__ __forceinline__ void p0_transpose_item(const float* W, int K, int Nsrc, bf16* WT, int k0, int nsrc0, int nout0, const float* ks, LAS float* scr, int lane) {
#pragma unroll 8
    for (int i = 0; i < 32; ++i) { const int kk = 2 * i + (lane >> 5); float v = W[(size_t)(k0 + kk) * Nsrc + nsrc0 + (lane & 31)]; if (ks) v *= ks[k0 + kk]; scr[kk * 33 + (lane & 31)] = v; }
    LDS_WAIT(); asm volatile("" ::: "memory");
    const int c = lane & 7;
#pragma unroll
    for (int j = 0; j < 4; ++j) { const int n = (lane >> 3) + 8 * j; const LAS float* s = scr + (8 * c) * 33 + n;
        v4u o; o.x = pk2(s[0 * 33], s[1 * 33]); o.y = pk2(s[2 * 33], s[3 * 33]); o.z = pk2(s[4 * 33], s[5 * 33]); o.w = pk2(s[6 * 33], s[7 * 33]);
        *(GAS v4u*)(WT + (size_t)(nout0 + n) * K + k0 + 8 * c) = o; }
    LDS_WAIT(); asm volatile("" ::: "memory");
}
struct Inputs { const float* p[27]; };
__device__ __forceinline__ void p0_prologue(Frame& F, const Inputs& I) {
    LAS float* scr = (LAS float*)(F.lds + RING_OFF + F.wave * 16384);
    const int gw = F.vcu * NWAVES + F.wave, NGW = F.G * NWAVES;
    constexpr int I_IN = 16 * 72, I_OUT = 16 * 32, I_GU = 16 * 176, I_DN = 44 * 32, I_SM = 4 * 8;
    constexpr int I_LAYER = I_IN + I_OUT + I_GU + I_DN + 2 * I_SM;
    for (int it = gw; it < DEPTH * I_LAYER; it += NGW) {
        const int l = it / I_LAYER; int r = it % I_LAYER;
        unsigned char* wl = F.ws + WS_W + (size_t)l * W_LAYER;
        if (r < I_IN) { const int kb = r / 72, nb = r % 72, n0 = nb * 32; int src = n0;
            if (n0 >= 1792) { const int q = n0 - 1792, j = q >> 8, rr = q & 255; src = ((rr >> 7) ? 2048 : 1792) + 128 * j + (rr & 127); }
            p0_transpose_item(I.p[2] + (size_t)l * DM * D_IN, DM, D_IN, (bf16*)(wl + WO_IN), kb * 64, src, n0, I.p[1] + l * DM, scr, F.lane); continue; }
        r -= I_IN;
        if (r < I_OUT) { const int kb = r / 32, nb = r % 32, k0 = kb * 64;
            const float* ks = k0 < 512 ? I.p[19] + l * 512 - 0 : (k0 < 768 ? I.p[20] + l * 256 - 512 : I.p[21] + l * 256 - 768);
            p0_transpose_item(I.p[22] + (size_t)l * DM * DM, DM, DM, (bf16*)(wl + WO_OUT), k0, nb * 32, nb * 32, ks, scr, F.lane); continue; }
        r -= I_OUT;
        if (r < I_GU) { const int kb = r / 176, nb = r % 176, n0 = nb * 32; const int j = n0 >> 8, rr = n0 & 255; const int src = ((rr >> 7) ? D_FF : 0) + 128 * j + (rr & 127);
            p0_transpose_item(I.p[24] + (size_t)l * DM * D_GU, DM, D_GU, (bf16*)(wl + WO_GU), kb * 64, src, n0, I.p[23] + l * DM, scr, F.lane); continue; }
        r -= I_GU;
        if (r < I_DN) { const int kb = r / 32, nb = r % 32;
            p0_transpose_item(I.p[25] + (size_t)l * D_FF * DM, D_FF, DM, (bf16*)(wl + WO_DN), kb * 64, nb * 32, nb * 32, nullptr, scr, F.lane); continue; }
        r -= I_DN;
        if (r < I_SM) { const int kb = r / 8, nb = r % 8;
            p0_transpose_item(I.p[11] + (size_t)l * 65536, 256, 256, (bf16*)(wl + WO_GLU), kb * 64, nb * 32, nb * 32, nullptr, scr, F.lane); continue; }
        r -= I_SM;
        { const int kb = r / 8, nb = r % 8;
            p0_transpose_item(I.p[17] + (size_t)l * 65536, 256, 256, (bf16*)(wl + WO_PW2), kb * 64, nb * 32, nb * 32, nullptr, scr, F.lane); }
    }
    const float* x = I.p[0]; bf16* hb = (bf16*)(F.ws + WS_HB); float* ssq = (float*)(F.ws + WS_SSQ);
    for (int m = gw; m < M; m += NGW) {
        const GAS f32x4* xr = (const GAS f32x4*)(x + (size_t)m * DM) + F.lane; f32x4 v[4]; float s = 0.f;
#pragma unroll
        for (int j = 0; j < 4; ++j) { v[j] = xr[64 * j]; s += (v[j].x * v[j].x + v[j].y * v[j].y) + (v[j].z * v[j].z + v[j].w * v[j].w); }
        s = wave_sum(s);
        GAS unsigned long long* o8 = (GAS unsigned long long*)(hb + (size_t)m * DM) + F.lane;
#pragma unroll
        for (int j = 0; j < 4; ++j) o8[64 * j] = (unsigned long long)pk2(v[j].x, v[j].y) | ((unsigned long long)pk2(v[j].z, v[j].w) << 32);
        if (F.lane < 16) ssq[(size_t)m * 16 + F.lane] = F.lane == 0 ? s : 0.f;
    }
    float* rope = (float*)(F.ws + WS_ROPE);
    for (int i = gw * 64 + F.lane; i < SEQ * 8; i += NGW * 64) { const int pos = i >> 3, f = i & 7;
        const float inv = powf(500000.0f, -(float)(2 * f) / 16.0f); const float ang = (float)pos * inv;
        rope[2 * i] = cosf(ang); rope[2 * i + 1] = sinf(ang); }
}

__device__ __forceinline__ void attn_naive_unit(Frame& F, int b, int h, int qb) {
    LAS float* km = (LAS float*)(F.lds);
    LAS unsigned* selm = (LAS unsigned*)(F.lds + 4096);
    LAS float* sc = (LAS float*)(F.lds + 8192) + F.wave * 1024;
    LAS float* qs = (LAS float*)(F.lds + 8192 + 8 * 4096) + F.wave * 64;
    const float* kmp = (const float*)(F.ws + WS_KMP); const float* Qf = (const float*)(F.ws + WS_QF);
    const bf16* Qb = (const bf16*)(F.ws + WS_QB); const bf16* Kb = (const bf16*)(F.ws + WS_KB); const bf16* Vb = (const bf16*)(F.ws + WS_VB); bf16* mix = (bf16*)(F.ws + WS_MIX);
    __syncthreads();
    for (int i = F.tid; i < 16 * 64; i += 512) { const int n = i >> 6, d = i & 63; float v = 0.f;
        if (n < qb) { const size_t idx = ((size_t)(b * NBLK + n) * 512) + h * 64 + d; v = (kmp[idx] + kmp[(size_t)BATCH * NBLK * 512 + idx]) * (1.0f / 256.0f); }
        km[i] = v; }
    __syncthreads();
    if (F.tid < 256) {
        const float* q = Qf + ((size_t)(b * SEQ + qb * 256 + F.tid)) * 512 + h * 64;
        float g[15];
#pragma unroll
        for (int n = 0; n < 15; ++n) g[n] = 0.f;
        for (int d4 = 0; d4 < 16; ++d4) { const f32x4 qv = *(const f32x4*)(q + 4 * d4);
#pragma unroll
            for (int n = 0; n < 15; ++n) { const LAS float* kk = km + n * 64 + 4 * d4; g[n] += (qv.x * kk[0] + qv.y * kk[1]) + (qv.z * kk[2] + qv.w * kk[3]); } }
        unsigned mask = 0u; const int topk = qb < 3 ? qb : 3;
        for (int k = 0; k < topk; ++k) { float best = -INFINITY; int bi = 0;
#pragma unroll
            for (int n = 0; n < 15; ++n) { const bool ok = n < qb && !((mask >> n) & 1u) && g[n] > best; best = ok ? g[n] : best; bi = ok ? n : bi; }
            mask |= 1u << bi; }
        selm[F.tid] = mask;
    }
    __syncthreads();
    for (int i = 0; i < 32; ++i) {
        const int t = F.wave * 32 + i, qpos = qb * 256 + t; const size_t row = (size_t)b * SEQ + qpos;
        const unsigned mask = selm[t] | (1u << qb);
        qs[F.lane] = bf2f(Qb[row * 512 + h * 64 + F.lane]);
        LDS_WAIT();
        int cnt = 0; float mx = -INFINITY;
        for (int n = 0; n <= qb; ++n) { if (!((mask >> n) & 1u)) continue;
            for (int kk = 0; kk < 4; ++kk) { const int key0 = n * 256 + kk * 64; if (key0 > qpos) break; const int key = key0 + F.lane;
                const v4u* kr = (const v4u*)(Kb + ((size_t)b * SEQ + key) * 512 + h * 64); float s = 0.f;
#pragma unroll
                for (int c = 0; c < 8; ++c) { const v4u w = kr[c]; const LAS float* qq = qs + 8 * c;
                    s += qq[0] * __uint_as_float(w.x << 16) + qq[1] * __uint_as_float(w.x & 0xffff0000u) + qq[2] * __uint_as_float(w.y << 16) + qq[3] * __uint_as_float(w.y & 0xffff0000u)
                       + qq[4] * __uint_as_float(w.z << 16) + qq[5] * __uint_as_float(w.z & 0xffff0000u) + qq[6] * __uint_as_float(w.w << 16) + qq[7] * __uint_as_float(w.w & 0xffff0000u); }
                if (key > qpos) s = -INFINITY;
                sc[cnt * 64 + F.lane] = s; mx = fmaxf(mx, s); ++cnt; } }
        mx = wave_max(mx); float l = 0.f;
        for (int c = 0; c < cnt; ++c) { const float p = exp2f(sc[c * 64 + F.lane] - mx); sc[c * 64 + F.lane] = p; l += p; }
        l = wave_sum(l); LDS_WAIT();
        float o = 0.f; int c = 0;
        for (int n = 0; n <= qb; ++n) { if (!((mask >> n) & 1u)) continue;
            for (int kk = 0; kk < 4; ++kk) { const int key0 = n * 256 + kk * 64; if (key0 > qpos) break;
                const bf16* vr = Vb + ((size_t)b * SEQ + key0) * 512 + h * 64 + F.lane;
#pragma unroll 8
                for (int j = 0; j < 64; ++j) o += sc[c * 64 + j] * bf2f(vr[(size_t)j * 512]);
                ++c; } }
        mix[row * DM + h * 64 + F.lane] = (bf16)f2bf(o / l);
        LDS_WAIT();
    }
}

__device__ __forceinline__ float gelu_tanh(float x) { const float u = 0.7978845608028654f * (x + 0.044715f * x * x * x); return 0.5f * x * (1.0f + tanhf(u)); }
__device__ __forceinline__ void ssm_naive_unit(Frame& F, const Inputs& I, int l, int b, int g) {
    const int p = F.lane, w = F.wave;
    LAS float* S = (LAS float*)(F.lds);
    const size_t gp = ((size_t)l * NGRP + g) * NST + p;
    const float dt = expf(I.p[5][l * NGRP + g]); const float lr = I.p[3][gp], li = I.p[4][gp];
    const float mag = expf(lr * dt); const float ar = mag * cosf(li * dt), ai = mag * sinf(li * dt);
    const float nr = ar - 1.0f, den = lr * lr + li * li; const float fr = (nr * lr + ai * li) / den, fi = (ai * lr - nr * li) / den;
    float bbr[16], bbi[16], cr[16], ci[16], dsk[16];
#pragma unroll
    for (int c = 0; c < 16; ++c) { const float br = I.p[6][gp * 16 + c], bi = I.p[7][gp * 16 + c]; bbr[c] = fr * br - fi * bi; bbi[c] = fr * bi + fi * br;
        const size_t ci_ = (((size_t)l * NGRP + g) * GCH + c) * NST + p; cr[c] = I.p[8][ci_]; ci[c] = I.p[9][ci_]; dsk[c] = I.p[10][(l * NGRP + g) * GCH + c]; }
    const bf16* Us = (const bf16*)(F.ws + WS_US); bf16* Z = (bf16*)(F.ws + WS_Z);
    const size_t row0 = (size_t)b * SEQ + w * 512;
    float hr = 0.f, hi = 0.f;
    for (int t = 0; t < 512; ++t) {
        const v4u* ur = (const v4u*)(Us + (row0 + t) * 256 + g * 16); const v4u u0 = ur[0], u1 = ur[1];
        const float uu[16] = {__uint_as_float(u0.x << 16), __uint_as_float(u0.x & 0xffff0000u), __uint_as_float(u0.y << 16), __uint_as_float(u0.y & 0xffff0000u), __uint_as_float(u0.z << 16), __uint_as_float(u0.z & 0xffff0000u), __uint_as_float(u0.w << 16), __uint_as_float(u0.w & 0xffff0000u),
                              __uint_as_float(u1.x << 16), __uint_as_float(u1.x & 0xffff0000u), __uint_as_float(u1.y << 16), __uint_as_float(u1.y & 0xffff0000u), __uint_as_float(u1.z << 16), __uint_as_float(u1.z & 0xffff0000u), __uint_as_float(u1.w << 16), __uint_as_float(u1.w & 0xffff0000u)};
        float xr = 0.f, xi = 0.f;
#pragma unroll
        for (int c = 0; c < 16; ++c) { xr += bbr[c] * uu[c]; xi += bbi[c] * uu[c]; }
        const float nr2 = ar * hr - ai * hi + xr, ni2 = ar * hi + ai * hr + xi; hr = nr2; hi = ni2;
    }
    __syncthreads();
    S[(w * 64 + p) * 2] = hr; S[(w * 64 + p) * 2 + 1] = hi;
    __syncthreads();
    float pr = ar, pi = ai;
#pragma unroll
    for (int k = 0; k < 9; ++k) { const float t0 = pr * pr - pi * pi, t1 = 2.0f * pr * pi; pr = t0; pi = t1; }
    hr = 0.f; hi = 0.f;
    for (int j = 0; j < w; ++j) { const float sr = S[(j * 64 + p) * 2], si = S[(j * 64 + p) * 2 + 1]; const float t0 = pr * hr - pi * hi + sr, t1 = pr * hi + pi * hr + si; hr = t0; hi = t1; }
    for (int t = 0; t < 512; ++t) {
        const v4u* ur = (const v4u*)(Us + (row0 + t) * 256 + g * 16); const v4u u0 = ur[0], u1 = ur[1];
        const float uu[16] = {__uint_as_float(u0.x << 16), __uint_as_float(u0.x & 0xffff0000u), __uint_as_float(u0.y << 16), __uint_as_float(u0.y & 0xffff0000u), __uint_as_float(u0.z << 16), __uint_as_float(u0.z & 0xffff0000u), __uint_as_float(u0.w << 16), __uint_as_float(u0.w & 0xffff0000u),
                              __uint_as_float(u1.x << 16), __uint_as_float(u1.x & 0xffff0000u), __uint_as_float(u1.y << 16), __uint_as_float(u1.y & 0xffff0000u), __uint_as_float(u1.z << 16), __uint_as_float(u1.z & 0xffff0000u), __uint_as_float(u1.w << 16), __uint_as_float(u1.w & 0xffff0000u)};
        float xr = 0.f, xi = 0.f;
#pragma unroll
        for (int c = 0; c < 16; ++c) { xr += bbr[c] * uu[c]; xi += bbi[c] * uu[c]; }
        const float nr2 = ar * hr - ai * hi + xr, ni2 = ar * hi + ai * hr + xi; hr = nr2; hi = ni2;
        float v[16];
#pragma unroll
        for (int c = 0; c < 16; ++c) v[c] = cr[c] * hr - ci[c] * hi;
        float v8[8], v4[4], v2[2], v1;
        { const bool up = (p & 32) != 0;
#pragma unroll
          for (int c = 0; c < 8; ++c) { const float keep = up ? v[c + 8] : v[c], send = up ? v[c] : v[c + 8]; v8[c] = keep + __shfl_xor(send, 32); } }
        { const bool up = (p & 16) != 0;
#pragma unroll
          for (int c = 0; c < 4; ++c) { const float keep = up ? v8[c + 4] : v8[c], send = up ? v8[c] : v8[c + 4]; v4[c] = keep + __shfl_xor(send, 16); } }
        { const bool up = (p & 8) != 0;
#pragma unroll
          for (int c = 0; c < 2; ++c) { const float keep = up ? v4[c + 2] : v4[c], send = up ? v4[c] : v4[c + 2]; v2[c] = keep + __shfl_xor(send, 8); } }
        { const bool up = (p & 4) != 0; const float keep = up ? v2[1] : v2[0], send = up ? v2[0] : v2[1]; v1 = keep + __shfl_xor(send, 4); }
        v1 += __shfl_xor(v1, 2); v1 += __shfl_xor(v1, 1);
        const int c = ((p >> 5) & 1) * 8 + ((p >> 4) & 1) * 4 + ((p >> 3) & 1) * 2 + ((p >> 2) & 1);
        float uc = uu[0], dc = dsk[0];
#pragma unroll
        for (int k = 1; k < 16; ++k) { uc = (c == k) ? uu[k] : uc; dc = (c == k) ? dsk[k] : dc; }
        const float y = v1 + dc * uc;
        if ((p & 3) == 0) Z[(row0 + t) * 256 + g * 16 + c] = (bf16)f2bf(gelu_tanh(y));
    }
}

__device__ __forceinline__ void conv_pre_token(Frame& F, const Inputs& I, int l, int row) {
    const bf16* Uc = (const bf16*)(F.ws + WS_UC); bf16* Yc = (bf16*)(F.ws + WS_YC);
    const int t = row & (SEQ - 1), c0 = 4 * F.lane;
    const float* cw = I.p[13] + (size_t)l * CWID * 256 + c0;
    f32x4 a = *(const f32x4*)(I.p[14] + l * 256 + c0);
    for (int j = 0; j < CWID; ++j) { const int tt = t - (CWID - 1) + j; if (tt < 0) continue;
        const unsigned long long uw = *(const unsigned long long*)(Uc + (size_t)(row - (CWID - 1) + j) * 256 + c0); const f32x4 w = *(const f32x4*)(cw + (size_t)j * 256);
        a.x += w.x * __uint_as_float((unsigned)uw << 16); a.y += w.y * __uint_as_float((unsigned)uw & 0xffff0000u);
        a.z += w.z * __uint_as_float((unsigned)(uw >> 32) << 16); a.w += w.w * __uint_as_float((unsigned)(uw >> 32) & 0xffff0000u); }
    const float mu = wave_sum((a.x + a.y) + (a.z + a.w)) * (1.0f / 256.0f);
    a = a - mu;
    const float var = wave_sum((a.x * a.x + a.y * a.y) + (a.z * a.z + a.w * a.w)) * (1.0f / 256.0f);
    const float rs = 1.0f / sqrtf(var + LN_EPS);
    const f32x4 g = *(const f32x4*)(I.p[15] + l * 256 + c0), bb = *(const f32x4*)(I.p[16] + l * 256 + c0);
    f32x4 y = a * rs * g + bb;
    y.x = y.x / (1.0f + __expf(-y.x)); y.y = y.y / (1.0f + __expf(-y.y)); y.z = y.z / (1.0f + __expf(-y.z)); y.w = y.w / (1.0f + __expf(-y.w));
    *(unsigned long long*)(Yc + (size_t)row * 256 + c0) = (unsigned long long)pk2(y.x, y.y) | ((unsigned long long)pk2(y.z, y.w) << 32);
}
__device__ __forceinline__ void attn_norm_row(Frame& F, int row) {
    bf16* mix = (bf16*)(F.ws + WS_MIX) + (size_t)row * DM + 8 * F.lane;
    const v4u w = *(const v4u*)mix;
    float v[8] = {__uint_as_float(w.x << 16), __uint_as_float(w.x & 0xffff0000u), __uint_as_float(w.y << 16), __uint_as_float(w.y & 0xffff0000u), __uint_as_float(w.z << 16), __uint_as_float(w.z & 0xffff0000u), __uint_as_float(w.w << 16), __uint_as_float(w.w & 0xffff0000u)};
    float s = 0.f;
#pragma unroll
    for (int k = 0; k < 8; ++k) s += v[k] * v[k];
    const float rs = 1.0f / sqrtf(wave_sum(s) * (1.0f / 512.0f) + RMS_EPS);
    v4u o; o.x = pk2(v[0] * rs, v[1] * rs); o.y = pk2(v[2] * rs, v[3] * rs); o.z = pk2(v[4] * rs, v[5] * rs); o.w = pk2(v[6] * rs, v[7] * rs);
    *(v4u*)mix = o;
}
__device__ __forceinline__ void final_norm_row(Frame& F, float* out, const float* gain, int row) {
    GAS f32x4* xr = (GAS f32x4*)(out + (size_t)row * DM) + F.lane; f32x4 v[4]; float s = 0.f;
#pragma unroll
    for (int j = 0; j < 4; ++j) { v[j] = xr[64 * j]; s += (v[j].x * v[j].x + v[j].y * v[j].y) + (v[j].z * v[j].z + v[j].w * v[j].w); }
    const float rs = 1.0f / sqrtf(wave_sum(s) * (1.0f / DM) + RMS_EPS);
#pragma unroll
    for (int j = 0; j < 4; ++j) { const f32x4 gg = *((const f32x4*)gain + F.lane + 64 * j); xr[64 * j] = v[j] * rs * gg; }
}

struct Args { Inputs in; float* out; unsigned char* ws; int ph_lo, ph_hi, li, pad; };
template <int PHM> __global__ void __launch_bounds__(NWAVES * 64, 2) skel_fwd(Args args) {
    extern __shared__ __attribute__((aligned(16))) unsigned char lds[];
#define FRAME() Frame F; { unsigned char* ws_ = args.ws; int t_ = threadIdx.x; asm volatile("" : "+s"(ws_), "+v"(t_)); F.lds = (LAS unsigned char*)lds; F.MISC = (volatile LAS unsigned*)(F.lds + MISC_OFF); \
        F.tid = t_; F.lane = t_ & 63; F.wave = __builtin_amdgcn_readfirstlane(t_ >> 6); F.G = gridDim.x; { const int bx = blockIdx.x; F.vcu = (F.G % 8 == 0) ? (bx % 8) * (F.G / 8) + bx / 8 : bx; } \
        F.ws = ws_; F.ctl = (gu32*)(ws_ + WS_CTL); } \
        bf16* const HB = (bf16*)(F.ws + WS_HB); float* const SSQ = (float*)(F.ws + WS_SSQ); bf16* const MIX = (bf16*)(F.ws + WS_MIX); const int gw = F.vcu * NWAVES + F.wave, NGW = F.G * NWAVES; (void)HB; (void)SSQ; (void)MIX; (void)gw; (void)NGW;
    LAS unsigned char* const lds0 = (LAS unsigned char*)lds;
    gu32* const ctl0 = (gu32*)(args.ws + WS_CTL);
    const Inputs& I = args.in;
    for (int u = threadIdx.x; u < (LDS_BYTES - LDSCTL_OFF) / 4; u += NWAVES * 64) ((LAS unsigned*)(lds0 + LDSCTL_OFF))[u] = 0u;
    __syncthreads();
    XcdBarrier bar; bar.bar = (unsigned*)(ctl0 + CW_BAR); bar.x = 0; bar.st = nullptr;
    if (MK_ONE_LAUNCH) bar = xcd_barrier_post((unsigned*)(ctl0 + CW_BAR), (volatile LAS unsigned*)(lds0 + MISC_OFF) + 8);
#define GRID_BAR() do { if (MK_ONE_LAUNCH) xcd_barrier(bar); } while (0)
    const int lo = args.ph_lo, hi = args.ph_hi;
#define PHON(t) (((PHM) >> (t)) & 1)
#define IN(k) (lo <= (k) && (k) < hi)
#define BOTH(k) (IN(k) && IN((k) + 1))

    if (PHON(0) && IN(0)) { FRAME(); p0_prologue(F, I); if (BOTH(0)) GRID_BAR(); }

    for (int l = 0; l < DEPTH; ++l) {
        const int pb = 1 + 6 * l;
#define WL() unsigned char* wl = F.ws + WS_W + (size_t)l * W_LAYER;
        if (PHON(1) && IN(pb)) { FRAME(); WL(); (void)wl;
            pg8::Gemm g{HB, (const bf16*)(wl + WO_IN), M, D_IN, DM}; pg8::StaticOrder S; S.init(M, D_IN, F.G, (int)blockIdx.x);
            pg8::EpiInProj E{SSQ, (const float*)(F.ws + WS_ROPE), (bf16*)(F.ws + WS_QB), (bf16*)(F.ws + WS_KB), (bf16*)(F.ws + WS_VB), (bf16*)(F.ws + WS_US), (bf16*)(F.ws + WS_UC), (float*)(F.ws + WS_QF), (float*)(F.ws + WS_KMP)};
            pg8::gemm_phase<pg8::EpiInProj, pg8::StaticOrder, true, true>(F.lds + RING_OFF, g, S, E);
            if (BOTH(pb)) GRID_BAR();
        }
        if (PHON(2) && IN(pb + 1)) { FRAME(); WL(); (void)wl;
            if (F.vcu < BATCH * NGRP) { ssm_naive_unit(F, I, l, F.vcu / NGRP, F.vcu % NGRP); }
            else { const int nw = (F.G - BATCH * NGRP) * NWAVES, w0 = (F.vcu - BATCH * NGRP) * NWAVES + F.wave; if (nw > 0) for (int r = w0; r < M; r += nw) conv_pre_token(F, I, l, r); }
            if (F.G <= BATCH * NGRP) { for (int r = gw; r < M; r += NGW) conv_pre_token(F, I, l, r); }
            for (int i = F.vcu; i < BATCH * NHEAD * NBLK; i += F.G) {
                const int j = i >> 8, v = i & 255, bh = v >> 2, c = v & 3, k = (j & 1) + 2 * c + 8 * (j >> 1); const int qb = (k & 1) ? 15 - (k >> 1) : (k >> 1);
                attn_naive_unit(F, bh >> 3, bh & 7, qb);
            }
            if (BOTH(pb + 1)) GRID_BAR();
        }
        if (PHON(3) && IN(pb + 2)) { FRAME(); WL(); (void)wl;
            for (int r = gw; r < M; r += NGW) attn_norm_row(F, r);
            int K256 = 256; asm volatile("" : "+s"(K256));
            for (int i = F.vcu; i < 256; i += F.G) {
#ifndef TAIL_SKIP0
                if (i < 128) { pg8::Gemm g{(const bf16*)(F.ws + WS_Z), (const bf16*)(wl + WO_GLU), M, 256, K256}; pg8::OneUnit S{i, true};
                    pg8::EpiRowNorm<0> E{(const bf16*)(F.ws + WS_Z), I.p[12] + l * 256, MIX, 512};
                    pg8::gemm_phase<pg8::EpiRowNorm<0>, pg8::OneUnit, false, true>(F.lds + RING_OFF, g, S, E); }
#endif
#ifndef TAIL_SKIP1
                if (i >= 128) { pg8::Gemm g{(const bf16*)(F.ws + WS_YC), (const bf16*)(wl + WO_PW2), M, 256, K256}; pg8::OneUnit S{i - 128, true};
                    pg8::EpiRowNorm<1> E{nullptr, I.p[18] + l * 256, MIX, 768};
                    pg8::gemm_phase<pg8::EpiRowNorm<1>, pg8::OneUnit, false, true>(F.lds + RING_OFF, g, S, E); }
#endif
            }
            if (BOTH(pb + 2)) GRID_BAR();
        }
        if (PHON(4) && IN(pb + 3)) { FRAME(); WL(); (void)wl;
            pg8::Gemm g{MIX, (const bf16*)(wl + WO_OUT), M, DM, DM}; pg8::StaticOrder S; S.init(M, DM, F.G, (int)blockIdx.x);
            pg8::EpiResid E{l == 0 ? I.p[0] : args.out, args.out, HB, SSQ};
            pg8::gemm_phase<pg8::EpiResid, pg8::StaticOrder, true, true>(F.lds + RING_OFF, g, S, E);
            if (BOTH(pb + 3)) GRID_BAR();
        }
        if (PHON(5) && IN(pb + 4)) { FRAME(); WL(); (void)wl;
            pg8::Gemm g{HB, (const bf16*)(wl + WO_GU), M, D_GU, DM}; pg8::StaticOrder S; S.init(M, D_GU, F.G, (int)blockIdx.x);
            pg8::EpiSwiGlu E{SSQ, (bf16*)(F.ws + WS_ACT)};
            pg8::gemm_phase<pg8::EpiSwiGlu, pg8::StaticOrder, true, true>(F.lds + RING_OFF, g, S, E);
            if (BOTH(pb + 4)) GRID_BAR();
        }
        if (PHON(6) && IN(pb + 5)) { FRAME(); WL(); (void)wl;
            pg8::Gemm g{(const bf16*)(F.ws + WS_ACT), (const bf16*)(wl + WO_DN), M, DM, D_FF}; pg8::StaticOrder S; S.init(M, DM, F.G, (int)blockIdx.x);
            pg8::EpiResid E{args.out, args.out, HB, SSQ};
            pg8::gemm_phase<pg8::EpiResid, pg8::StaticOrder, true, true>(F.lds + RING_OFF, g, S, E);
            if (BOTH(pb + 5)) GRID_BAR();
        }
    }
    if (PHON(7) && IN(13)) { FRAME(); for (int r = gw; r < M; r += NGW) final_norm_row(F, args.out, I.p[26], r); }
#undef IN
#undef BOTH
}

typedef void (*kern_t)(Args);
static int phase_type(int p) { return p == 0 ? 0 : (p == 13 ? 7 : 1 + (p - 1) % 6); }
extern "C" void kernel_launch(void* const* d_in, const int* in_sizes, int n_in, void* d_out, int out_size, void* d_ws, size_t ws_size, hipStream_t stream) {
    static int grid = 0;
#if MK_ONE_LAUNCH
    static const kern_t kerns[1] = {skel_fwd<0xff>}; constexpr int NK = 1;
#else
    static const kern_t kerns[8] = {skel_fwd<0x01>, skel_fwd<0x02>, skel_fwd<0x04>, skel_fwd<0x08>, skel_fwd<0x10>, skel_fwd<0x20>, skel_fwd<0x40>, skel_fwd<0x80>}; constexpr int NK = 8;
#endif
    if (grid == 0) {
        if (n_in != 27 || out_size != M * DM || ws_size < WS_END) { fprintf(stderr, "kernel_launch: unexpected shapes: n_in %d out %d ws %zu\n", n_in, out_size, ws_size); grid = -1; return; }
        int dev = 0, cus = 0;
        if (hipGetDevice(&dev) != hipSuccess || hipDeviceGetAttribute(&cus, hipDeviceAttributeMultiprocessorCount, dev) != hipSuccess) { grid = -1; return; }
        for (int k = 0; k < NK; ++k) if (hipFuncSetAttribute((const void*)kerns[k], hipFuncAttributeMaxDynamicSharedMemorySize, LDS_BYTES) != hipSuccess) { fprintf(stderr, "kernel_launch: hipFuncSetAttribute failed\n"); grid = -1; return; }
        (void)hipGetLastError();
        grid = cus;
    }
    if (grid < 0) return;
    if (hipMemsetAsync((char*)d_ws + WS_CTL, 0, CTL_ZERO_BYTES, stream) != hipSuccess) return;
    Args a{};
    for (int i = 0; i < 27; ++i) a.in.p[i] = (const float*)d_in[i];
    a.out = (float*)d_out; a.ws = (unsigned char*)d_ws;
#if MK_ONE_LAUNCH
    a.ph_lo = 0; a.ph_hi = N_PHASES; a.li = 0; hipLaunchKernelGGL(kerns[0], dim3(grid), dim3(NWAVES * 64), LDS_BYTES, stream, a);
#else
    for (int p = 0; p < N_PHASES; ++p) { a.ph_lo = p; a.ph_hi = p + 1; a.li = p; hipLaunchKernelGGL(kerns[phase_type(p)], dim3(grid), dim3(NWAVES * 64), LDS_BYTES, stream, a); }
#endif
}
```

```cpp
#include <hip/hip_runtime.h>
#include <cstdio>
#include <cstdint>
namespace pg8 {
#define PG8_LAS __attribute__((address_space(3)))
typedef unsigned short bf16_t;
typedef short bf16x8 __attribute__((ext_vector_type(8)));
typedef float f32x4 __attribute__((ext_vector_type(4)));
typedef unsigned u32x4 __attribute__((ext_vector_type(4)));
constexpr int BM = 256, BK = 64, HALF = 128, HTB = HALF * BK * 2  , STAGE_BYTES = 8 * HTB, NXCD = 8, WGM = 8;

__host__ __device__ __forceinline__ int lds_byte(int r, int c) { const int st = (r >> 4) * 2 + (c >> 5), rr = r & 15, cc = c & 31, ob = rr * 64 + cc * 2; return st * 1024 + (ob ^ (((ob >> 9) & 1) << 5)); }
__host__ __device__ __forceinline__ void stage_rc(int b, int& R, int& C) { const int st = b / 1024, sb = b % 1024, swz = sb ^ (((sb >> 9) & 1) << 5); R = (st >> 1) * 16 + swz / 64; C = (st & 1) * 32 + (swz % 64) / 2; }
__host__ __device__ __forceinline__ int perm32(int rho) { const int n = rho >> 4, i = rho & 15; return 8 * (i >> 2) + 4 * n + (i & 3); }

struct Unit { int pm, pn; };
struct Gemm { const bf16_t* A; const bf16_t* Bt; int M, N, K; };

struct StaticOrder {
    int nM, nN, nwg, G, c;
    __host__ __device__ void init(int M, int N, int G_, int c_) { nM = M / BM; nN = N / BM; nwg = nM * nN; G = G_; c = c_; }
    __host__ __device__ bool next(int i, Unit& u) const {
        const long L = (long)i * G + c; if (L >= nwg) return false;
        int wgid = (int)L; { const int q = nwg / NXCD, r = nwg % NXCD, xcd = wgid % NXCD, off = wgid / NXCD; wgid = (xcd < r ? xcd * (q + 1) : r * (q + 1) + (xcd - r) * q) + off; }
        const int nig = WGM * nN, gid = wgid / nig, fm = gid * WGM, gsz = (nM - fm) < WGM ? (nM - fm) : WGM;
        u.pm = fm + ((wgid % nig) % gsz); u.pn = (wgid % nig) / gsz; return true;
    }
    __device__ __forceinline__ void a_ready(const Unit&) const {}
    __device__ __forceinline__ void done(const Unit&) const {}
};

__device__ __forceinline__ unsigned cvt_pk_bf16(float lo, float hi) { unsigned r; asm volatile("v_cvt_pk_bf16_f32 %0, %1, %2" : "=v"(r) : "v"(lo), "v"(hi)); return r; }
typedef float f32x2 __attribute__((ext_vector_type(2)));
}

namespace mdl {
constexpr int BATCH = 8, SEQ = 4096, DM = 1024, M = BATCH * SEQ, DEPTH = 2;
constexpr int D_ATTN = 512, NHEAD = 8, HD = 64, D_SSM = 256, D_CONV = 256, NGRP = 16, GCH = 16, NST = 64, CWID = 31;
constexpr int D_IN = 2304, D_FF = 2816, D_GU = 5632, NBLK = SEQ / 256;
constexpr float RMS_EPS = 1e-6f, LN_EPS = 1e-5f;
constexpr float C2 = 0.125f * 1.4426950408889634f;
}

namespace pg8 {
typedef unsigned u32x2 __attribute__((ext_vector_type(2)));
__device__ __forceinline__ float shx(float v, int m, int lane) { return __builtin_bit_cast(float, __builtin_amdgcn_ds_bpermute((lane ^ m) << 2, __builtin_bit_cast(int, v))); }
__device__ __forceinline__ float row_rstd16(const float* ssq, int row, float inv_n, float eps) {
    const f32x4* p = (const f32x4*)(ssq + (size_t)row * 16); const f32x4 a = p[0], b = p[1], c = p[2], d = p[3];
    const float s = ((a[0] + a[1]) + (a[2] + a[3])) + ((b[0] + b[1]) + (b[2] + b[3])) + ((c[0] + c[1]) + (c[2] + c[3])) + ((d[0] + d[1]) + (d[2] + d[3]));
    return 1.0f / sqrtf(s * inv_n + eps);
}
__device__ __forceinline__ float sigmoidf_(float x) { return 1.0f / (1.0f + __expf(-x)); }

struct EpiInProj {
    static constexpr bool PERM = true, AFTER_DRAIN = false;
    const float* ssq; const float* rope; bf16_t *Qb, *Kb, *Vb, *Us, *Uc; float* Qf; float* kmp;
    __device__ __forceinline__ void operator()(const f32x4 (&acc)[2][2][4][2], const Unit& u, int wr, int wc, int fr, int fq) const {
        asm volatile("" : "+v"(fr), "+v"(fq)); const int ln = fq * 16 + fr;
        const int pn = u.pn, rowb = u.pm * BM + wr * 64 + fr, lcol = wc * 32 + fq * 8;
        const bool isq = pn < 2, isk = (pn == 2 || pn == 3);
        if (isq || isk) {
            const bool rotw = (wc & 1) == 0;
            const bool rot = rotw && fq < 2; const float sgn = fq == 0 ? -1.f : 1.f;
            f32x4 cs[2][2];
#pragma unroll
            for (int bj = 0; bj < 2; ++bj)
#pragma unroll
                for (int n = 0; n < 2; ++n) cs[bj][n] = (f32x4){0.f, 0.f, 0.f, 0.f};
            bf16_t* O = isq ? Qb : Kb; const int ct = isq ? pn : pn - 2;
#pragma unroll
            for (int ai = 0; ai < 2; ++ai)
#pragma unroll
                for (int m = 0; m < 4; ++m) {
                    const int row = rowb + ai * HALF + m * 16; const float rs = row_rstd16(ssq, row, 1.0f / 1024.0f, mdl::RMS_EPS);
                    f32x4 v[2][2];
#pragma unroll
                    for (int bj = 0; bj < 2; ++bj)
#pragma unroll
                        for (int n = 0; n < 2; ++n) v[bj][n] = acc[ai][bj][m][n] * rs;
                    if (rotw) {
                        const f32x4* rp = (const f32x4*)(rope + (size_t)(row & (mdl::SEQ - 1)) * 16);
                        const f32x4 r0 = rp[0], r1 = rp[1], r2 = rp[2], r3 = rp[3];
                        const float cc[2][4] = {{r0[0], r0[2], r1[0], r1[2]}, {r2[0], r2[2], r3[0], r3[2]}}, ss[2][4] = {{r0[1], r0[3], r1[1], r1[3]}, {r2[1], r2[3], r3[1], r3[3]}};
#pragma unroll
                        for (int bj = 0; bj < 2; ++bj)
#pragma unroll
                            for (int n = 0; n < 2; ++n)
#pragma unroll
                                for (int i = 0; i < 4; ++i) { const float x = v[bj][n][i], p = shx(x, 16, ln); if (rot) v[bj][n][i] = x * cc[n][i] + sgn * p * ss[n][i]; }
                    }
#pragma unroll
                    for (int bj = 0; bj < 2; ++bj) {
                        const size_t off = (size_t)row * 512 + ct * 256 + bj * HALF + lcol;
                        const float sc = isq ? mdl::C2 : 1.0f;
                        u32x4 w; w.x = cvt_pk_bf16(v[bj][0][0] * sc, v[bj][0][1] * sc); w.y = cvt_pk_bf16(v[bj][0][2] * sc, v[bj][0][3] * sc); w.z = cvt_pk_bf16(v[bj][1][0] * sc, v[bj][1][1] * sc); w.w = cvt_pk_bf16(v[bj][1][2] * sc, v[bj][1][3] * sc);
                        *(u32x4*)(O + off) = w;
                        if (isq) { *(f32x4*)(Qf + off) = v[bj][0]; *(f32x4*)(Qf + off + 4) = v[bj][1]; }
                        else { cs[bj][0] += v[bj][0]; cs[bj][1] += v[bj][1]; }
                    }
                }
            if (isk) {
#pragma unroll
                for (int bj = 0; bj < 2; ++bj)
#pragma unroll
                    for (int n = 0; n < 2; ++n)
#pragma unroll
                        for (int i = 0; i < 4; ++i) { float s = cs[bj][n][i]; s += shx(s, 1, ln); s += shx(s, 2, ln); s += shx(s, 4, ln); s += shx(s, 8, ln); cs[bj][n][i] = s; }
                if (fr == 0) {
                    float* kp = kmp + ((size_t)(wr * mdl::BATCH * mdl::NBLK + u.pm) * 512) + ct * 256 + lcol;
#pragma unroll
                    for (int bj = 0; bj < 2; ++bj) { *(f32x4*)(kp + bj * HALF) = cs[bj][0]; *(f32x4*)(kp + bj * HALF + 4) = cs[bj][1]; }
                }
            }
        } else if (pn < 7) {
            bf16_t* O = pn == 6 ? Us : Vb; const int ld = pn == 6 ? 256 : 512, ct = pn == 6 ? 0 : pn - 4;
#pragma unroll
            for (int ai = 0; ai < 2; ++ai)
#pragma unroll
                for (int m = 0; m < 4; ++m) {
                    const int row = rowb + ai * HALF + m * 16; const float rs = row_rstd16(ssq, row, 1.0f / 1024.0f, mdl::RMS_EPS);
#pragma unroll
                    for (int bj = 0; bj < 2; ++bj) { const f32x4 v0 = acc[ai][bj][m][0] * rs, v1 = acc[ai][bj][m][1] * rs;
                        u32x4 w; w.x = cvt_pk_bf16(v0[0], v0[1]); w.y = cvt_pk_bf16(v0[2], v0[3]); w.z = cvt_pk_bf16(v1[0], v1[1]); w.w = cvt_pk_bf16(v1[2], v1[3]);
                        *(u32x4*)(O + (size_t)row * ld + ct * 256 + bj * HALF + lcol) = w; }
                }
        } else {
            const int ct = pn - 7;
#pragma unroll
            for (int ai = 0; ai < 2; ++ai)
#pragma unroll
                for (int m = 0; m < 4; ++m) {
                    const int row = rowb + ai * HALF + m * 16; const float rs = row_rstd16(ssq, row, 1.0f / 1024.0f, mdl::RMS_EPS);
                    float o[8];
#pragma unroll
                    for (int n = 0; n < 2; ++n)
#pragma unroll
                        for (int i = 0; i < 4; ++i) { const float a = acc[ai][0][m][n][i] * rs, g = acc[ai][1][m][n][i] * rs; o[n * 4 + i] = a * sigmoidf_(g); }
                    u32x4 w; w.x = cvt_pk_bf16(o[0], o[1]); w.y = cvt_pk_bf16(o[2], o[3]); w.z = cvt_pk_bf16(o[4], o[5]); w.w = cvt_pk_bf16(o[6], o[7]);
                    *(u32x4*)(Uc + (size_t)row * 256 + ct * HALF + lcol) = w;
                }
        }
    }
};

struct EpiResid {
    static constexpr bool PERM = false, AFTER_DRAIN = false;
    const float* base; float* out; bf16_t* hb; float* ssq;
    __device__ __forceinline__ void operator()(const f32x4 (&acc)[2][2][4][2], const Unit& u, int wr, int wc, int fr, int fq) const {
        asm volatile("" : "+v"(fr), "+v"(fq)); const int ln = fq * 16 + fr;
        const int col0 = u.pn * BM + wc * 32 + 4 * fq;
#pragma unroll
        for (int ai = 0; ai < 2; ++ai)
#pragma unroll
            for (int m = 0; m < 4; ++m) {
                const int row = u.pm * BM + ai * HALF + wr * 64 + m * 16 + fr; const size_t off = (size_t)row * mdl::DM + col0; float s = 0.f;
#pragma unroll
                for (int bj = 0; bj < 2; ++bj)
#pragma unroll
                    for (int n = 0; n < 2; ++n) { const f32x4 o = *(const f32x4*)(base + off + bj * HALF + n * 16) + acc[ai][bj][m][n];
                        *(f32x4*)(out + off + bj * HALF + n * 16) = o; s += (o[0] * o[0] + o[1] * o[1]) + (o[2] * o[2] + o[3] * o[3]);
                        u32x2 w; w.x = cvt_pk_bf16(o[0], o[1]); w.y = cvt_pk_bf16(o[2], o[3]); *(u32x2*)(hb + off + bj * HALF + n * 16) = w; }
                s += shx(s, 16, ln); s += shx(s, 32, ln);
                if (fq == 0) ssq[(size_t)row * 16 + u.pn * 4 + wc] = s;
                if (m & 1) asm volatile("" ::: "memory");
            }
    }
};

struct EpiSwiGlu {
    static constexpr bool PERM = true, AFTER_DRAIN = false;
    const float* ssq; bf16_t* act;
    __device__ __forceinline__ void operator()(const f32x4 (&acc)[2][2][4][2], const Unit& u, int wr, int wc, int fr, int fq) const {
        asm volatile("" : "+v"(fr), "+v"(fq)); const int ln = fq * 16 + fr;
        const int col0 = u.pn * HALF + wc * 32 + fq * 8;
#pragma unroll
        for (int ai = 0; ai < 2; ++ai)
#pragma unroll
            for (int m = 0; m < 4; ++m) {
                const int row = u.pm * BM + ai * HALF + wr * 64 + m * 16 + fr; const float rs = row_rstd16(ssq, row, 1.0f / 1024.0f, mdl::RMS_EPS);
                float o[8];
#pragma unroll
                for (int n = 0; n < 2; ++n)
#pragma unroll
                    for (int i = 0; i < 4; ++i) { const float g = acc[ai][0][m][n][i] * rs, up = acc[ai][1][m][n][i] * rs; o[n * 4 + i] = g * sigmoidf_(g) * up; }
                u32x4 w; w.x = cvt_pk_bf16(o[0], o[1]); w.y = cvt_pk_bf16(o[2], o[3]); w.z = cvt_pk_bf16(o[4], o[5]); w.w = cvt_pk_bf16(o[6], o[7]);
                *(u32x4*)(act + (size_t)row * mdl::D_FF + col0) = w;
            }
    }
};

template <int MODE> struct EpiRowNorm {
    static constexpr bool PERM = true, AFTER_DRAIN = true;
    const bf16_t* z; const float* bias; bf16_t* out; int ocol;
    __device__ __forceinline__ void fused(f32x4 (&acc)[2][2][4][2], const Unit& u, int wr, int wc, int fr, int fq, PG8_LAS unsigned char* lds, int wid, int lane) const {
        asm volatile("" : "+v"(fr), "+v"(fq)); const int ln = fq * 16 + fr;
        PG8_LAS float* P = (PG8_LAS float*)lds;
        const int lcol = wc * 32 + fq * 8;
        f32x4 bv[2][2];
#pragma unroll
        for (int bj = 0; bj < 2; ++bj)
#pragma unroll
            for (int n = 0; n < 2; ++n) bv[bj][n] = *(const f32x4*)(bias + bj * HALF + lcol + 4 * n);
#pragma unroll
        for (int ai = 0; ai < 2; ++ai)
#pragma unroll
            for (int m = 0; m < 4; ++m) {
                const int lrow = ai * HALF + wr * 64 + m * 16 + fr, row = u.pm * BM + lrow; float s = 0.f;
#pragma unroll
                for (int bj = 0; bj < 2; ++bj) {
                    f32x4 v0 = acc[ai][bj][m][0] + bv[bj][0], v1 = acc[ai][bj][m][1] + bv[bj][1];
                    if (MODE == 0) {
                        const u32x4 zz = *(const u32x4*)(z + (size_t)row * 256 + bj * HALF + lcol);
                        const float z0 = __uint_as_float(zz.x << 16), z1 = __uint_as_float(zz.x & 0xffff0000u), z2 = __uint_as_float(zz.y << 16), z3 = __uint_as_float(zz.y & 0xffff0000u);
                        const float z4 = __uint_as_float(zz.z << 16), z5 = __uint_as_float(zz.z & 0xffff0000u), z6 = __uint_as_float(zz.w << 16), z7 = __uint_as_float(zz.w & 0xffff0000u);
                        v0 = (f32x4){z0 * sigmoidf_(v0[0]), z1 * sigmoidf_(v0[1]), z2 * sigmoidf_(v0[2]), z3 * sigmoidf_(v0[3])};
                        v1 = (f32x4){z4 * sigmoidf_(v1[0]), z5 * sigmoidf_(v1[1]), z6 * sigmoidf_(v1[2]), z7 * sigmoidf_(v1[3])};
                    }
                    acc[ai][bj][m][0] = v0; acc[ai][bj][m][1] = v1;
                    s += (v0[0] * v0[0] + v0[1] * v0[1]) + (v0[2] * v0[2] + v0[3] * v0[3]) + (v1[0] * v1[0] + v1[1] * v1[1]) + (v1[2] * v1[2] + v1[3] * v1[3]);
                }
                s += shx(s, 16, ln); s += shx(s, 32, ln);
                if (fq == 0) P[lrow * 4 + wc] = s;
                asm volatile("" ::: "memory");
            }
        asm volatile("s_waitcnt lgkmcnt(0)" ::: "memory"); __builtin_amdgcn_s_barrier(); asm volatile("" ::: "memory");
#pragma unroll
        for (int ai = 0; ai < 2; ++ai)
#pragma unroll
            for (int m = 0; m < 4; ++m) {
                const int lrow = ai * HALF + wr * 64 + m * 16 + fr, row = u.pm * BM + lrow;
                const f32x4 pp = *(const PG8_LAS f32x4*)(P + lrow * 4); const float rs = 1.0f / sqrtf(((pp[0] + pp[1]) + (pp[2] + pp[3])) * (1.0f / 256.0f) + mdl::RMS_EPS);
#pragma unroll
                for (int bj = 0; bj < 2; ++bj) { const f32x4 v0 = acc[ai][bj][m][0] * rs, v1 = acc[ai][bj][m][1] * rs;
                    u32x4 w; w.x = cvt_pk_bf16(v0[0], v0[1]); w.y = cvt_pk_bf16(v0[2], v0[3]); w.z = cvt_pk_bf16(v1[0], v1[1]); w.w = cvt_pk_bf16(v1[2], v1[3]);
                    *(u32x4*)(out + (size_t)row * mdl::DM + ocol + bj * HALF + lcol) = w; }
                asm volatile("" ::: "memory");
            }
        asm volatile("s_waitcnt lgkmcnt(0)" ::: "memory"); __builtin_amdgcn_s_barrier(); asm volatile("" ::: "memory");
    }
};
struct OneUnit {
    int pm; bool on;
    __device__ __forceinline__ bool next(int i, Unit& u) const { if (i > 0 || !on) return false; u.pm = pm; u.pn = 0; return true; }
    __device__ __forceinline__ void a_ready(const Unit&) const {}
    __device__ __forceinline__ void done(const Unit&) const {}
};
}
namespace pg8 {
template <class Epi, class Sched, bool ALIGN_EPI = false, bool SP2 = false>
__device__ __forceinline__ void gemm_phase(PG8_LAS unsigned char* lds, const Gemm g, const Sched& S, const Epi& E) {
    int tid_ = threadIdx.x; asm volatile("" : "+v"(tid_));
    const int tid = tid_, wid = __builtin_amdgcn_readfirstlane(tid >> 6), lane = tid & 63, wr = wid >> 2, wc = wid & 3, fr = lane & 15, fq = lane >> 4;
    const int K = g.K, nt = K / BK;
    unsigned voffA[2], voffB[2];
#pragma unroll
    for (int i = 0; i < 2; ++i) { int R, C; stage_rc(tid * 16 + i * 8192, R, C); const int Rb = Epi::PERM ? ((R & ~31) + perm32(R & 31)) : R;
        voffA[i] = (unsigned)(R * K + C) * 2u; voffB[i] = (unsigned)(Rb * K + C) * 2u; }
    const size_t kstep = (size_t)(BK * 2);
    const size_t hstep = (size_t)HALF * K * 2;
    const size_t tstep = 2 * hstep;
    const unsigned ldsw = (unsigned)wid * 1024u;
    const int aoff = lds_byte(wr * 64 + fr, fq * 8), boff = lds_byte(wc * 32 + fr, fq * 8);
#define PG8_SA(b, h) (((b) * 2 + (h)) * HTB)
#define PG8_SB(b, h) ((4 + (b) * 2 + (h)) * HTB)
#define PG8_STAGE(bufoff, gbase, voff) do { _Pragma("unroll") for (int _i = 0; _i < 2; ++_i) \
        __builtin_amdgcn_global_load_lds((const unsigned*)((const char*)(gbase) + (voff)[_i]), (PG8_LAS unsigned*)(lds + (bufoff) + ldsw + _i * 8192), 16, 0, 0); } while (0)
#define PG8_LDA(dst, b, h) do { _Pragma("unroll") for (int m = 0; m < 4; ++m) _Pragma("unroll") for (int k = 0; k < 2; ++k) dst[m][k] = *(const PG8_LAS bf16x8*)(lds + PG8_SA(b, h) + aoff + m * 2048 + k * 1024); } while (0)
#define PG8_LDB(dst, b, h) do { _Pragma("unroll") for (int n = 0; n < 2; ++n) _Pragma("unroll") for (int k = 0; k < 2; ++k) dst[n][k] = *(const PG8_LAS bf16x8*)(lds + PG8_SB(b, h) + boff + n * 2048 + k * 1024); } while (0)
#define PG8_MMA(ai, bj, At, Bt) do { __builtin_amdgcn_s_setprio(1); _Pragma("unroll") for (int m = 0; m < 4; ++m) _Pragma("unroll") for (int n = 0; n < 2; ++n) _Pragma("unroll") for (int k = 0; k < 2; ++k) \
        acc[ai][bj][m][n] = __builtin_amdgcn_mfma_f32_16x16x32_bf16(Bt[n][k], At[m][k], acc[ai][bj][m][n], 0, 0, 0); __builtin_amdgcn_s_setprio(0); } while (0)
#define PG8_WAIT_V(n) asm volatile("s_waitcnt vmcnt(" #n ")" ::: "memory")
#define PG8_WAIT_L(n) asm volatile("s_waitcnt lgkmcnt(" #n ")" ::: "memory")
#define PG8_BAR __builtin_amdgcn_s_barrier()
#define PG8_SCHED __builtin_amdgcn_sched_barrier(0)
    Unit cur, nxt; int ui = 0;
    if (!S.next(0, cur)) return;
    f32x4 acc[2][2][4][2];
#pragma unroll
    for (int a = 0; a < 2; ++a)
#pragma unroll
        for (int b = 0; b < 2; ++b)
#pragma unroll
            for (int m = 0; m < 4; ++m)
#pragma unroll
                for (int n = 0; n < 2; ++n) acc[a][b][m][n] = (f32x4){0.f, 0.f, 0.f, 0.f};
    bf16x8 At[4][2], B0[2][2], B1[2][2];
    const char* cA = (const char*)g.A + (size_t)cur.pm * tstep; const char* cB = (const char*)g.Bt + (size_t)cur.pn * tstep;
    S.a_ready(cur);
    if constexpr (SP2) {
        PG8_STAGE(PG8_SB(0, 0), cB, voffB); PG8_STAGE(PG8_SB(0, 1), cB + hstep, voffB); PG8_STAGE(PG8_SA(0, 0), cA, voffA); PG8_STAGE(PG8_SA(0, 1), cA + hstep, voffA);
        if (wr == 1) PG8_BAR;
        PG8_WAIT_V(2); PG8_BAR;
        PG8_STAGE(PG8_SB(1, 0), cB + kstep, voffB); PG8_STAGE(PG8_SA(1, 0), cA + kstep, voffA); PG8_STAGE(PG8_SB(1, 1), cB + hstep + kstep, voffB);
        PG8_WAIT_V(6); PG8_BAR;
    } else {
        PG8_STAGE(PG8_SB(0, 0), cB, voffB); PG8_STAGE(PG8_SA(0, 0), cA, voffA); PG8_STAGE(PG8_SB(0, 1), cB + hstep, voffB); PG8_STAGE(PG8_SA(0, 1), cA + hstep, voffA);
        if (wr == 1) PG8_BAR;
        PG8_WAIT_V(4); PG8_BAR;
        PG8_STAGE(PG8_SB(1, 0), cB + kstep, voffB); PG8_STAGE(PG8_SA(1, 0), cA + kstep, voffA); PG8_STAGE(PG8_SB(1, 1), cB + hstep + kstep, voffB);
        PG8_WAIT_V(6); PG8_BAR;
    }
    for (;;) {
        const bool has_next = S.next(ui + 1, nxt);
        const char* nA = has_next ? (const char*)g.A + (size_t)nxt.pm * tstep : cA; const char* nB = has_next ? (const char*)g.Bt + (size_t)nxt.pn * tstep : cB;
        for (int t = 0; t < nt; t += 2) {
            const bool last = (t == nt - 2);
            const char* a1 = cA + (size_t)(t + 1) * kstep;
            const char* a2 = last ? nA : cA + (size_t)(t + 2) * kstep; const char* b2 = last ? nB : cB + (size_t)(t + 2) * kstep;
            const char* a3 = a2 + kstep; const char* b3 = b2 + kstep;
            if (last && has_next) S.a_ready(nxt);
            if constexpr (SP2) {
            PG8_LDB(B0, 0, 0); PG8_LDB(B1, 0, 1); PG8_SCHED; PG8_LDA(At, 0, 0); PG8_STAGE(PG8_SA(1, 1), a1 + hstep, voffA);
            PG8_WAIT_V(8); PG8_WAIT_L(0); PG8_BAR; PG8_MMA(0, 0, At, B0); PG8_MMA(0, 1, At, B1); PG8_BAR; PG8_SCHED;
            PG8_LDA(At, 0, 1); PG8_STAGE(PG8_SB(0, 0), b2, voffB); PG8_STAGE(PG8_SB(0, 1), b2 + hstep, voffB); PG8_STAGE(PG8_SA(0, 0), a2, voffA);
            PG8_WAIT_V(8); PG8_WAIT_L(0); PG8_BAR; PG8_MMA(1, 0, At, B0); PG8_MMA(1, 1, At, B1); PG8_BAR; PG8_SCHED;
            PG8_LDB(B0, 1, 0); PG8_LDB(B1, 1, 1); PG8_SCHED; PG8_LDA(At, 1, 0); PG8_STAGE(PG8_SA(0, 1), a2 + hstep, voffA);
            PG8_WAIT_V(8); PG8_WAIT_L(0); PG8_BAR; PG8_MMA(0, 0, At, B0); PG8_MMA(0, 1, At, B1); PG8_BAR; PG8_SCHED;
            PG8_LDA(At, 1, 1); PG8_STAGE(PG8_SB(1, 0), b3, voffB); PG8_STAGE(PG8_SB(1, 1), b3 + hstep, voffB); PG8_STAGE(PG8_SA(1, 0), a3, voffA);
            PG8_WAIT_V(8); PG8_WAIT_L(0); PG8_BAR; PG8_MMA(1, 0, At, B0); PG8_MMA(1, 1, At, B1); PG8_BAR; PG8_SCHED;
            } else {
            PG8_LDB(B0, 0, 0); PG8_SCHED; PG8_LDA(At, 0, 0); PG8_STAGE(PG8_SA(1, 1), a1 + hstep, voffA);
            PG8_WAIT_L(8); PG8_BAR; PG8_WAIT_L(0); PG8_MMA(0, 0, At, B0); PG8_BAR; PG8_SCHED;
            PG8_LDB(B1, 0, 1); PG8_STAGE(PG8_SB(0, 0), b2, voffB);
            PG8_BAR; PG8_WAIT_L(0); PG8_MMA(0, 1, At, B1); PG8_BAR;
            PG8_LDA(At, 0, 1); PG8_STAGE(PG8_SA(0, 0), a2, voffA);
            PG8_BAR; PG8_WAIT_L(0); PG8_MMA(1, 0, At, B0); PG8_BAR; PG8_SCHED;
            PG8_STAGE(PG8_SB(0, 1), b2 + hstep, voffB);
            PG8_WAIT_V(6); PG8_BAR; PG8_MMA(1, 1, At, B1); PG8_BAR;
            PG8_LDB(B0, 1, 0); PG8_SCHED; PG8_LDA(At, 1, 0); PG8_STAGE(PG8_SA(0, 1), a2 + hstep, voffA);
            PG8_WAIT_L(8); PG8_BAR; PG8_WAIT_L(0); PG8_MMA(0, 0, At, B0); PG8_BAR; PG8_SCHED;
            PG8_LDB(B1, 1, 1); PG8_STAGE(PG8_SB(1, 0), b3, voffB);
            PG8_BAR; PG8_WAIT_L(0); PG8_MMA(0, 1, At, B1); PG8_BAR;
            PG8_LDA(At, 1, 1); PG8_STAGE(PG8_SA(1, 0), a3, voffA);
            PG8_BAR; PG8_WAIT_L(0); PG8_MMA(1, 0, At, B0); PG8_BAR; PG8_SCHED;
            PG8_STAGE(PG8_SB(1, 1), b3 + hstep, voffB);
            PG8_WAIT_V(6); PG8_BAR; PG8_MMA(1, 1, At, B1); PG8_BAR;
            }
        }
        if constexpr (ALIGN_EPI) { if (wr == 0) PG8_BAR; }
        if constexpr (!Epi::AFTER_DRAIN) { E(acc, cur, wr, wc, fr, fq); S.done(cur); }
        if (!has_next) break;
#pragma unroll
        for (int a = 0; a < 2; ++a)
#pragma unroll
            for (int b = 0; b < 2; ++b)
#pragma unroll
                for (int m = 0; m < 4; ++m)
#pragma unroll
                    for (int n = 0; n < 2; ++n) acc[a][b][m][n] = (f32x4){0.f, 0.f, 0.f, 0.f};
        cur = nxt; cA = nA; cB = nB; ++ui;
        if constexpr (ALIGN_EPI) { if (wr == 1) PG8_BAR; }
    }
    PG8_WAIT_V(0);
    if constexpr (!ALIGN_EPI) { if (wr == 0) PG8_BAR; }
    PG8_BAR;
    if constexpr (Epi::AFTER_DRAIN) { E.fused(acc, cur, wr, wc, fr, fq, lds, wid, lane); S.done(cur); }
#undef PG8_SA
#undef PG8_SB
#undef PG8_STAGE
#undef PG8_LDA
#undef PG8_LDB
#undef PG8_MMA
#undef PG8_WAIT_V
#undef PG8_WAIT_L
#undef PG8_BAR
#undef PG8_SCHED
}
}
#include <hip/hip_bf16.h>
#include <cmath>
namespace attn_body {
using bf16=__hip_bfloat16;
using bf16x8=__attribute__((ext_vector_type(8)))short;
using s16x4=__attribute__((ext_vector_type(4)))short;
using f32x16=__attribute__((ext_vector_type(16)))float;
using u32x4=__attribute__((ext_vector_type(4)))unsigned;
constexpr int BATCH=8,NHEAD=8,SEQ=4096,D=64,DM=NHEAD*D,OP=1024;
constexpr int NW=8,QBLK=32,QB=QBLK*NW,KVBLK=64,NQB=SEQ/QB;
constexpr int ATTN_PITCH=DM, ATTN_UNIT_ROWS=QB;
__device__ __forceinline__ int crow(int r,int hi){return (r&3)+8*(r>>2)+4*hi;}
#define SBAR() __builtin_amdgcn_sched_barrier(0)
__device__ __forceinline__ void cmask(f32x16&p0,f32x16&p1,int jb,int qrel,int hi){
  const float NEG=-INFINITY; int kb=64*jb+4*hi;
  #pragma unroll
  for(int r=0;r<16;++r){int kv=kb+(r&3)+8*(r>>2); if(kv>qrel)p0[r]=NEG; if(kv+32>qrel)p1[r]=NEG;}
}

constexpr int NSLOT=3, SLOTB=8192;
constexpr int LDS_K=0, LDS_V=NSLOT*SLOTB, LDS_WS=2*NSLOT*SLOTB, LDS_OST=LDS_WS+NW*64*4, LDS_BYTES=LDS_OST+NW*4096;
constexpr float C2=0.125f*1.4426950408889634f;
__device__ __forceinline__ void glds16(const void*gsrc,unsigned lds_dst){unsigned keep;
  asm volatile("s_mov_b32 %0, m0\n\ts_mov_b32 m0, %2\n\ts_nop 0\n\tglobal_load_lds_dwordx4 %1, off\n\ts_mov_b32 m0, %0":"=&s"(keep):"v"(gsrc),"s"(lds_dst):"memory");}
__device__ __forceinline__ float max3f(float a,float b,float c){float r;asm("v_max3_f32 %0, %1, %2, %3":"=v"(r):"v"(a),"v"(b),"v"(c));return r;}
__device__ __forceinline__ float max2f(float a,float b){float r;asm("v_max_f32_e32 %0, %1, %2":"=v"(r):"v"(a),"v"(b));return r;}
__device__ __forceinline__ float fadd_s(float a,float b){float r;asm("v_add_f32_e32 %0, %1, %2":"=v"(r):"v"(a),"v"(b));return r;}
__device__ __forceinline__ float fsub_s(float a,float b){float r;asm("v_sub_f32_e32 %0, %1, %2":"=v"(r):"v"(a),"v"(b));return r;}
typedef float f32x2_t __attribute__((ext_vector_type(2))); typedef __bf16 bf16x2_t __attribute__((ext_vector_type(2)));
__device__ __forceinline__ unsigned cvtpk_s(float lo,float hi){f32x2_t v={lo,hi};bf16x2_t b=__builtin_convertvector(v,bf16x2_t);return __builtin_bit_cast(unsigned,b);}
#define WAIT_BAR(N) asm volatile("s_waitcnt vmcnt(" #N ") lgkmcnt(0)\n\ts_barrier":::"memory")

__device__ __forceinline__ void qkt(f32x16&p0,f32x16&p1,const char*Kslot,const bf16x8*qr,const f32x16&negm,int r32,int hi){
  const char*kb=Kslot+hi*1024+r32*16;
  #pragma unroll
  for(int d0=0;d0<4;++d0){
    const bf16x8 b0=*reinterpret_cast<const bf16x8*>(kb+d0*2048);
    const bf16x8 b1=*reinterpret_cast<const bf16x8*>(kb+d0*2048+512);
    if(d0==0){p0=__builtin_amdgcn_mfma_f32_32x32x16_bf16(b0,qr[0],negm,0,0,0);p1=__builtin_amdgcn_mfma_f32_32x32x16_bf16(b1,qr[0],negm,0,0,0);}
    else{p0=__builtin_amdgcn_mfma_f32_32x32x16_bf16(b0,qr[d0],p0,0,0,0);p1=__builtin_amdgcn_mfma_f32_32x32x16_bf16(b1,qr[d0],p1,0,0,0);}}
}
typedef __attribute__((address_space(3))) const char* lds_cptr;
typedef short v4i16_t __attribute__((ext_vector_type(4)));
__device__ __forceinline__ void kload8(bf16x8*kf,lds_cptr kp){
  kf[0]=*(const __attribute__((address_space(3))) bf16x8*)(kp);      kf[1]=*(const __attribute__((address_space(3))) bf16x8*)(kp+512);
  kf[2]=*(const __attribute__((address_space(3))) bf16x8*)(kp+2048); kf[3]=*(const __attribute__((address_space(3))) bf16x8*)(kp+2560);
  kf[4]=*(const __attribute__((address_space(3))) bf16x8*)(kp+4096); kf[5]=*(const __attribute__((address_space(3))) bf16x8*)(kp+4608);
  kf[6]=*(const __attribute__((address_space(3))) bf16x8*)(kp+6144); kf[7]=*(const __attribute__((address_space(3))) bf16x8*)(kp+6656);
}
__device__ __forceinline__ void kload2(bf16x8*kf,lds_cptr kp,int j){ kf[2*j]=*(const __attribute__((address_space(3))) bf16x8*)(kp+j*2048); kf[2*j+1]=*(const __attribute__((address_space(3))) bf16x8*)(kp+j*2048+512); }
__device__ __forceinline__ s16x4 vtr(lds_cptr p){ return __builtin_bit_cast(s16x4,__builtin_amdgcn_ds_read_tr16_b64_v4i16((__attribute__((address_space(3))) v4i16_t*)p)); }
__device__ __forceinline__ float rowmax(const f32x16&p0,const f32x16&p1){
  float a=max3f(p0[0],p0[1],p1[0]),b=max3f(p0[2],p0[3],p1[1]);a=max3f(a,p1[2],p1[3]);
  #pragma unroll
  for(int r=4;r<16;r+=4){a=max3f(a,p0[r],p0[r+1]);b=max3f(b,p0[r+2],p0[r+3]);a=max3f(a,p1[r],p1[r+1]);b=max3f(b,p1[r+2],p1[r+3]);}
  const float m=max2f(a,b);
  auto rr=__builtin_amdgcn_permlane32_swap(__float_as_uint(m),__float_as_uint(m),false,false);
  return max2f(__uint_as_float(rr[0]),__uint_as_float(rr[1]));
}
__device__ __forceinline__ void pv(f32x16*o,int vb,bf16x8 pa0,bf16x8 pa1,bf16x8 pa2,bf16x8 pa3){
  #pragma unroll
  for(int d0=0;d0<2;++d0){s16x4 lo[4],hi[4];
    #pragma unroll
    for(int ks=0;ks<4;++ks){
      asm volatile("ds_read_b64_tr_b16 %0,%1 offset:%c2":"=&v"(lo[ks]):"v"(vb),"i"(d0*4096+ks*1024):"memory");
      asm volatile("ds_read_b64_tr_b16 %0,%1 offset:%c2":"=&v"(hi[ks]):"v"(vb),"i"(d0*4096+ks*1024+512):"memory");}
    asm volatile("s_waitcnt lgkmcnt(0)":::"memory");SBAR();
    #define PK(k) (bf16x8){lo[k][0],lo[k][1],lo[k][2],lo[k][3],hi[k][0],hi[k][1],hi[k][2],hi[k][3]}
    o[d0]=__builtin_amdgcn_mfma_f32_32x32x16_bf16(pa0,PK(0),o[d0],0,0,0);
    o[d0]=__builtin_amdgcn_mfma_f32_32x32x16_bf16(pa1,PK(1),o[d0],0,0,0);
    o[d0]=__builtin_amdgcn_mfma_f32_32x32x16_bf16(pa2,PK(2),o[d0],0,0,0);
    o[d0]=__builtin_amdgcn_mfma_f32_32x32x16_bf16(pa3,PK(3),o[d0],0,0,0);
    #undef PK
  }
}

#ifndef ATTN_STORE16
#define ATTN_STORE16(p,v) (*(u32x4*)(p)=(v))
#endif
#define KT(s) ((s)<4?4*qb+(s):(s)-4)
template<int THRL> __device__ __forceinline__ void attn_unit(int b,int h,int qb,unsigned selbits,const bf16*Q,const bf16*__restrict__ K,const bf16*__restrict__ V,bf16*O,char*shm){
  int tid_=threadIdx.x; asm volatile("":"+v"(tid_));
  const int tid=tid_,lane=tid&63,r32=lane&31,hi=lane>>5; const int wid=__builtin_amdgcn_readfirstlane(tid>>6);
  const long rowbase=(long)b*SEQ; const int q0=qb*QB;
  const bf16*Qw=Q+(rowbase+q0+wid*QBLK)*DM+h*D;
  const bf16*Kh=K+rowbase*DM+h*D,*Vh=V+rowbase*DM+h*D;
  const unsigned lds0=(unsigned)(uintptr_t)shm;
  float*wsf=(float*)(shm+LDS_WS)+wid*64;
  const bf16*ksrc=Kh+(long)lane*DM+wid*8;
  const bf16*vsrc=Vh+(long)(16*(wid&3)+(lane>>2))*DM+(wid>>2)*32+(lane&3)*8;
  const unsigned kdst=lds0+LDS_K+wid*1024, vdst=lds0+LDS_V+wid*1024;
  #define DMA_K(t,slot) glds16(ksrc+(long)KT(t)*KVBLK*DM,(unsigned)__builtin_amdgcn_readfirstlane(kdst+(slot)))
  #define DMA_V(t,slot) glds16(vsrc+(long)KT(t)*KVBLK*DM,(unsigned)__builtin_amdgcn_readfirstlane(vdst+(slot)))
  const int vb0=(int)(lds0+LDS_V)+((lane>>4)&1)*32+(lane&3)*8+(4*hi+((lane&15)>>2))*64;
  const char*Kbase=shm+LDS_K; bf16x8 kf[8];
  const lds_cptr shm3=(lds_cptr)shm; const lds_cptr kp0=shm3+LDS_K+hi*1024+r32*16; const lds_cptr vp0=shm3+LDS_V+((lane>>4)&1)*32+(lane&3)*8+(4*hi+((lane&15)>>2))*64;
  const int NT=(q0+QB)/KVBLK;
  DMA_K(0,0);DMA_V(0,0);DMA_K(1,SLOTB);
  bf16x8 qr[4];
  #pragma unroll
  for(int d0=0;d0<4;++d0)qr[d0]=*reinterpret_cast<const bf16x8*>(&Qw[(long)r32*DM+d0*16+hi*8]);
  float mhat=0.f,l_reg=0.f;f32x16 o[2];o[0]=f32x16{};o[1]=f32x16{};const f32x16 zero16=f32x16{};
  const int qrel=wid*QBLK+r32;
  #define CMASK(P0,P1,t) do{ if((t)<4){cmask(P0,P1,(t),qrel,hi);} }while(0)
  bool resc=false;
  #define START(P0,P1) do{ const float rm=rowmax(P0,P1); resc=false; \
    { const float dl=rm; mhat=fadd_s(mhat,dl); \
      _Pragma("unroll") for(int r=0;r<16;++r){P0[r]=fsub_s(P0[r],dl);P1[r]=fsub_s(P1[r],dl);} \
      } \
    _Pragma("unroll") for(int r=0;r<16;++r)P0[r]=__builtin_amdgcn_exp2f(P0[r]); }while(0)
  #define RESC() do{ if(resc){ asm volatile("s_waitcnt lgkmcnt(0)":::"memory"); \
      _Pragma("unroll") for(int d_=0;d_<2;++d_) _Pragma("unroll") for(int r=0;r<16;++r)o[d_][r]*=wsf[crow(r,hi)]; } }while(0)
  f32x16 pA0,pA1,pB0,pB1;
  int sl_prev=0,sl_cur=0,sl_next=SLOTB;
  #define ROT() do{sl_prev=sl_cur;sl_cur=sl_next;sl_next=(sl_next==(NSLOT-1)*SLOTB)?0:sl_next+SLOTB;}while(0)
  DMA_K(2,2*SLOTB);
  WAIT_BAR(3);
  qkt(pA0,pA1,Kbase,qr,zero16,r32,hi);asm volatile("s_nop 15\n\ts_nop 7":"+v"(pA0),"+v"(pA1));CMASK(pA0,pA1,0);
  START(pA0,pA1);
  _Pragma("unroll") for(int r=0;r<16;++r)pA1[r]=__builtin_amdgcn_exp2f(pA1[r]);
  WAIT_BAR(0);
  DMA_K(3,0);DMA_V(1,SLOTB);
  ROT();
  kload8(kf,kp0+sl_cur);
  WAIT_BAR(2);
  s16x4 vlo[8],vhi[8]; u32x4 pw0,pw1,pw2,pw3;
  #define PKW(P,B) cvtpk_s(P[B],P[B+1])
  #define PAF(k) __builtin_bit_cast(bf16x8,pw##k)
  #define VFR(i) (bf16x8){vlo[i][0],vlo[i][1],vlo[i][2],vlo[i][3],vhi[i][0],vhi[i][1],vhi[i][2],vhi[i][3]}
  #define PIN(x) asm volatile("":"+v"(x))
  #define MX3(a,b,c) __builtin_fmaxf(__builtin_fmaxf((a),(b)),(c))
  #define GAPA(MF,A0,A1,A2,A3,W0,W1,PW) do{ MF; sacc+=A0; sacc+=A1; sacc+=A2; sacc+=A3; PIN(sacc); W0; W1; PIN(PW); SBAR(); }while(0)
  #define EX(v) __builtin_amdgcn_exp2f(v)
  #define GAPB(MF,X,B) do{ MF; X[B]=EX(X[B]); X[B+1]=EX(X[B+1]); X[B+2]=EX(X[B+2]); X[B+3]=EX(X[B+3]); PIN(X); SBAR(); }while(0)
  #define VRD(i) do{ vlo[i]=vtr(vp_+(((i)>>2)*4096+((i)&3)*1024)); vhi[i]=vtr(vp_+(((i)>>2)*4096+((i)&3)*1024+512)); }while(0)
  #define KRD(G,j) do{ if(G){ kload2(kf,kp0+sl_next,j); SBAR(); } }while(0)
    \
  #define STEP(C0,C1,P0,P1,t,GK,GV,GL) do{ SBAR(); \
    { const float nm_=(((t)<4)||((selbits>>(((t)-4)>>2))&1u))?-mhat:-INFINITY; _Pragma("unroll") for(int r_=0;r_<16;++r_){C0[r_]=nm_;C1[r_]=nm_;} PIN(C0); PIN(C1); SBAR(); } \
    const lds_cptr vp_=vp0+sl_prev; \
    VRD(0); SBAR(); float sacc=(P0[0]+P0[1]); \
    GAPA(C0=__builtin_amdgcn_mfma_f32_32x32x16_bf16(kf[0],qr[0],C0,0,0,0), P0[2],P0[3],P0[4],P0[5],     pw0[0]=PKW(P0,0), pw0[1]=PKW(P0,2), pw0); \
    VRD(4); SBAR(); GAPA(C1=__builtin_amdgcn_mfma_f32_32x32x16_bf16(kf[1],qr[0],C1,0,0,0), P0[6],P0[7],P0[8],P0[9],     pw0[2]=PKW(P0,4), pw0[3]=PKW(P0,6), pw0); \
    VRD(1); SBAR(); GAPA(C0=__builtin_amdgcn_mfma_f32_32x32x16_bf16(kf[2],qr[1],C0,0,0,0),   P0[10],P0[11],P0[12],P0[13], pw1[0]=PKW(P0,8), pw1[1]=PKW(P0,10), pw1); \
    VRD(5); SBAR(); GAPA(C1=__builtin_amdgcn_mfma_f32_32x32x16_bf16(kf[3],qr[1],C1,0,0,0),   P0[14],P0[15],P1[0],P1[1],   pw1[2]=PKW(P0,12),pw1[3]=PKW(P0,14), pw1); \
    VRD(2); SBAR(); GAPA(C0=__builtin_amdgcn_mfma_f32_32x32x16_bf16(kf[4],qr[2],C0,0,0,0),   P1[2],P1[3],P1[4],P1[5],     pw2[0]=PKW(P1,0), pw2[1]=PKW(P1,2), pw2); \
    VRD(6); SBAR(); GAPA(C1=__builtin_amdgcn_mfma_f32_32x32x16_bf16(kf[5],qr[2],C1,0,0,0),   P1[6],P1[7],P1[8],P1[9],     pw2[2]=PKW(P1,4), pw2[3]=PKW(P1,6), pw2); \
    VRD(3); SBAR(); GAPA(C0=__builtin_amdgcn_mfma_f32_32x32x16_bf16(kf[6],qr[3],C0,0,0,0),   P1[10],P1[11],P1[12],P1[13], pw3[0]=PKW(P1,8), pw3[1]=PKW(P1,10), pw3); \
    VRD(7); SBAR(); GAPA(C1=__builtin_amdgcn_mfma_f32_32x32x16_bf16(kf[7],qr[3],C1,0,0,0),   P1[14],P1[15],0.f,0.f,       pw3[2]=PKW(P1,12),pw3[3]=PKW(P1,14), pw3); \
    l_reg+=sacc; \
    if(GK){DMA_K((t)+3,sl_cur);} if(GV){DMA_V((t)+1,sl_next);} \
    CMASK(C0,C1,t); \
    { float a=MX3(C0[0],C0[1],C1[0]),b=MX3(C0[2],C0[3],C1[1]); a=MX3(a,C1[2],C1[3]); \
      _Pragma("unroll") for(int r=4;r<16;r+=4){a=MX3(a,C0[r],C0[r+1]);b=MX3(b,C0[r+2],C0[r+3]);a=MX3(a,C1[r],C1[r+1]);b=MX3(b,C1[r+2],C1[r+3]);} \
      float rm=__builtin_fmaxf(a,b); { auto rr=__builtin_amdgcn_permlane32_swap(__float_as_uint(rm),__float_as_uint(rm),false,false); rm=__builtin_fmaxf(__uint_as_float(rr[0]),__uint_as_float(rr[1])); } \
      resc=false; \
      if(__builtin_expect(__any(rm>(float)THRL),0)){ const float dl=__builtin_fmaxf(rm,0.f); mhat+=dl; \
        _Pragma("unroll") for(int r=0;r<16;++r){C0[r]-=dl;C1[r]-=dl;} \
        const float f=__builtin_amdgcn_exp2f(-dl); l_reg*=f; if(hi==0)wsf[r32]=f; resc=true; } } \
    SBAR(); \
    GAPB(o[0]=__builtin_amdgcn_mfma_f32_32x32x16_bf16(PAF(0),VFR(0),o[0],0,0,0), C0,0); \
    GAPB(o[1]=__builtin_amdgcn_mfma_f32_32x32x16_bf16(PAF(0),VFR(4),o[1],0,0,0), C0,4); \
    KRD(GL,0); GAPB(o[0]=__builtin_amdgcn_mfma_f32_32x32x16_bf16(PAF(1),VFR(1),o[0],0,0,0), C0,8); \
    KRD(GL,1); GAPB(o[1]=__builtin_amdgcn_mfma_f32_32x32x16_bf16(PAF(1),VFR(5),o[1],0,0,0), C0,12); \
    KRD(GL,2); GAPB(o[0]=__builtin_amdgcn_mfma_f32_32x32x16_bf16(PAF(2),VFR(2),o[0],0,0,0), C1,0); \
    KRD(GL,3); GAPB(o[1]=__builtin_amdgcn_mfma_f32_32x32x16_bf16(PAF(2),VFR(6),o[1],0,0,0), C1,4); \
    GAPB(o[0]=__builtin_amdgcn_mfma_f32_32x32x16_bf16(PAF(3),VFR(3),o[0],0,0,0), C1,8); \
    GAPB(o[1]=__builtin_amdgcn_mfma_f32_32x32x16_bf16(PAF(3),VFR(7),o[1],0,0,0), C1,12); \
    }while(0)
  int t=1;
  for(;t+5<NT;t+=2){
    STEP(pB0,pB1,pA0,pA1,t,true,true,true);     WAIT_BAR(2); RESC(); ROT();
    STEP(pA0,pA1,pB0,pB1,t+1,true,true,true);   WAIT_BAR(2); RESC(); ROT();
  }
  #define ENDW(tt) do{ if((tt)+3<NT){WAIT_BAR(2);} else if((tt)+2<NT){WAIT_BAR(1);} else {WAIT_BAR(0);} }while(0)
  for(;t+1<NT;t+=2){
    STEP(pB0,pB1,pA0,pA1,t,(t+3<NT),(t+1<NT),(t+1<NT));       ENDW(t);   RESC(); ROT();
    STEP(pA0,pA1,pB0,pB1,t+1,(t+4<NT),(t+2<NT),(t+2<NT));     ENDW(t+1); RESC(); ROT();
  }
  STEP(pB0,pB1,pA0,pA1,NT-1,false,false,false); RESC();
  { float sacc=pB0[0]+pB0[1]; _Pragma("unroll") for(int r=2;r<16;++r)sacc+=pB0[r]; _Pragma("unroll") for(int r=0;r<16;++r)sacc+=pB1[r]; l_reg+=sacc;
    pw0=(u32x4){PKW(pB0,0),PKW(pB0,2),PKW(pB0,4),PKW(pB0,6)};pw1=(u32x4){PKW(pB0,8),PKW(pB0,10),PKW(pB0,12),PKW(pB0,14)};pw2=(u32x4){PKW(pB1,0),PKW(pB1,2),PKW(pB1,4),PKW(pB1,6)};pw3=(u32x4){PKW(pB1,8),PKW(pB1,10),PKW(pB1,12),PKW(pB1,14)};
    SBAR(); pv(o,vb0+sl_cur,PAF(0),PAF(1),PAF(2),PAF(3)); }
  #undef PKW
  #undef PAF
  #undef VFR
  #undef PIN
  #undef MX3
  #undef GAPA
  #undef GAPB
  #undef EX
  #undef VRD
  #undef KRD
  #undef STEP
  #undef ENDW
  {auto rr=__builtin_amdgcn_permlane32_swap(__float_as_uint(l_reg),__float_as_uint(l_reg),false,false);l_reg=__uint_as_float(rr[0])+__uint_as_float(rr[1]);}
  if(hi==0)wsf[32+r32]=l_reg;asm volatile("s_waitcnt lgkmcnt(0)":::"memory");
  float rli[16];
  #pragma unroll
  for(int r=0;r<16;++r)rli[r]=__builtin_amdgcn_rcpf(wsf[32+crow(r,hi)]);
  bf16*Ow=O+(rowbase+q0+wid*QBLK)*OP+h*D;
  { bf16*stg=(bf16*)(shm+LDS_OST)+wid*2048;
    #pragma unroll
    for(int r=0;r<16;++r){const int orow=crow(r,hi);
      #pragma unroll
      for(int d0=0;d0<2;++d0)stg[orow*64+d0*32+r32]=__float2bfloat16(o[d0][r]*rli[r]);}
    asm volatile("s_waitcnt lgkmcnt(0)":::"memory");
    #pragma unroll
    for(int i=0;i<4;++i){const int row=i*8+(lane>>3),ch=lane&7; const u32x4 v=*(const u32x4*)(stg+row*64+ch*8); ATTN_STORE16(Ow+(long)row*OP+ch*8,v);} }
  asm volatile("s_waitcnt lgkmcnt(0)\n\ts_barrier":::"memory");
  #undef DMA_K
  #undef DMA_V
  #undef CMASK
  #undef START
  #undef RESC
  #undef ROT
}
constexpr int ATTN_LDS_BYTES=LDS_BYTES;
#undef KT
#undef SBAR
#undef WAIT_BAR
}
#define GAS __attribute__((address_space(1)))
#define LAS __attribute__((address_space(3)))
typedef unsigned short bf16;
typedef unsigned v4u __attribute__((ext_vector_type(4)));
typedef float f32x4 __attribute__((ext_vector_type(4)));
typedef short bf16x8 __attribute__((ext_vector_type(8)));
typedef GAS unsigned gu32;
typedef GAS unsigned long long gu64;
#define RLX_AGENT __ATOMIC_RELAXED, __HIP_MEMORY_SCOPE_AGENT
#define LDS_WAIT() asm volatile("s_waitcnt lgkmcnt(0)" ::: "memory")
#define VM_WAIT() asm volatile("s_waitcnt vmcnt(0)" ::: "memory")
__device__ __forceinline__ unsigned long long rt() { return __builtin_amdgcn_s_memrealtime(); }
__device__ __forceinline__ unsigned f2bf(float f) { unsigned u = __builtin_bit_cast(unsigned, f); return (u + 0x7fffu + ((u >> 16) & 1u)) >> 16; }
__device__ __forceinline__ unsigned pk2(float lo, float hi) { return f2bf(lo) | (f2bf(hi) << 16); }

#define XB_TMO      128
#define XB_XCNT(j)  (256  + 64 * (j))
#define XB_XSUB(j)  (1280 + 64 * (j))
#define XB_XGEN(j)  (2304 + 64 * (j))
#define XB_TOP      3328
#define XB_TOPGEN   3392
#define XCD_BAR_WORDS 3456
#define XB_SPIN_CAP (1u << 18)

__device__ __forceinline__ unsigned xb_ld(unsigned* p)              { return __hip_atomic_load(p, __ATOMIC_RELAXED, __HIP_MEMORY_SCOPE_AGENT); }
__device__ __forceinline__ unsigned xb_add(unsigned* p, unsigned v) { return __hip_atomic_fetch_add(p, v, __ATOMIC_RELAXED, __HIP_MEMORY_SCOPE_AGENT); }
__device__ __forceinline__ unsigned xb_xcc_id() { return (unsigned)__builtin_amdgcn_s_getreg((3 << 11) | 20) & 0xFu; }
#define XB_SPIN(cond, bar) do { unsigned _sp = 0; while (cond) { __builtin_amdgcn_s_sleep(1); \
    if ((++_sp & 255u) == 0u) { if (xb_ld(&(bar)[XB_TMO])) break; if (_sp > XB_SPIN_CAP) { atomicAdd(&(bar)[XB_TMO], 1u); break; } } } } while (0)

struct XcdBarrier {
    unsigned* bar; unsigned x;
    volatile LAS unsigned* st;
};

__device__ __forceinline__ XcdBarrier xcd_barrier_post(unsigned* bar, volatile LAS unsigned* st) {
    XcdBarrier b; b.bar = bar; b.x = xb_xcc_id(); b.st = st;
    if (threadIdx.x == 0) (void)xb_add(&bar[XB_XCNT(b.x)], 1u);
    return b;
}
__device__ __forceinline__ void xcd_barrier_complete(unsigned* bar, unsigned x, unsigned& nloc, unsigned& nx) {
    const unsigned G = gridDim.x * gridDim.y * gridDim.z;
    unsigned sum, cnt, mine, sp = 0u;
    for (;;) {
        sum = 0u; cnt = 0u; mine = 0u;
#pragma unroll
        for (unsigned j = 0; j < 16; ++j) { const unsigned c = xb_ld(&bar[XB_XCNT(j)]); sum += c; cnt += (c > 0u) ? 1u : 0u; mine = (j == x) ? c : mine; }
        if (sum == G) break;
        __builtin_amdgcn_s_sleep(1);
        if ((++sp & 255u) == 0u) { if (xb_ld(&bar[XB_TMO])) break; if (sp > XB_SPIN_CAP) { atomicAdd(&bar[XB_TMO], 1u); break; } }
    }
    nloc = mine > 0u ? mine : 1u; nx = cnt > 0u ? cnt : 1u;
}

__device__ __forceinline__ void xcd_barrier(const XcdBarrier& b) {
    asm volatile("s_waitcnt vmcnt(0)" ::: "memory");
    __syncthreads();
    if (threadIdx.x == 0) {
        unsigned* bar = b.bar;
        __builtin_amdgcn_s_waitcnt(0);
        unsigned nloc = b.st[0], nx = b.st[1];
        if (nloc == 0u) { xcd_barrier_complete(bar, b.x, nloc, nx); b.st[0] = nloc; b.st[1] = nx; }
        const unsigned old = xb_add(&bar[XB_XSUB(b.x)], 1u);
        const unsigned gen = old / nloc;
        if (old + 1u == (gen + 1u) * nloc) {
            __builtin_amdgcn_fence(__ATOMIC_RELEASE, "agent");
            asm volatile("s_waitcnt vmcnt(0)" ::: "memory");
            const unsigned og = xb_add(&bar[XB_TOP], 1u);
            const unsigned tg = og / nx;
            if (og + 1u == (tg + 1u) * nx) xb_add(&bar[XB_TOPGEN], 1u);
            else XB_SPIN(xb_ld(&bar[XB_TOPGEN]) == tg, bar);
            __builtin_amdgcn_fence(__ATOMIC_ACQUIRE, "agent");
            xb_add(&bar[XB_XGEN(b.x)], 1u);
            asm volatile("s_waitcnt vmcnt(0)" ::: "memory");
        } else {
            XB_SPIN(xb_ld(&bar[XB_XGEN(b.x)]) == gen, bar);
            __builtin_amdgcn_fence(__ATOMIC_ACQUIRE, "agent");
            asm volatile("s_waitcnt vmcnt(0)" ::: "memory");
        }
    }
    __syncthreads();
}

using namespace mdl;
constexpr int NWAVES = 8;
#ifndef ATTN_NAIVE
#define ATTN_NAIVE 0
#endif
#ifndef MK_ONE_LAUNCH
#define MK_ONE_LAUNCH 1
#endif
constexpr int N_PHASES = 14;
constexpr size_t MiB = 1u << 20;
constexpr size_t WS_CTL = 0, CTL_ZERO_BYTES = 1 * MiB;
constexpr size_t WS_ROPE = 1 * MiB;
constexpr size_t WS_KMP = 1 * MiB + 512 * 1024;
constexpr size_t WS_SSQ = 2 * MiB;
constexpr size_t WS_W = 8 * MiB, W_LAYER = 24 * MiB;
constexpr size_t WO_IN = 0, WO_OUT = 5 * MiB, WO_GU = 7 * MiB, WO_DN = 18 * MiB, WO_GLU = 23 * MiB + 512 * 1024, WO_PW2 = 23 * MiB + 768 * 1024;
constexpr size_t WS_HB = 64 * MiB;
constexpr size_t WS_QB = 128 * MiB, WS_KB = 160 * MiB, WS_VB = 192 * MiB, WS_QF = 224 * MiB, WS_US = 288 * MiB, WS_UC = 304 * MiB, WS_Z = 320 * MiB, WS_YC = 336 * MiB, WS_MIX = 352 * MiB;
constexpr size_t WS_ACT = 128 * MiB;
constexpr size_t WS_END = 416 * MiB;
static_assert(WS_ACT + (size_t)M * D_FF * 2 <= WS_UC + 16 * MiB && WS_MIX + (size_t)M * DM * 2 <= WS_END, "d_ws map");
constexpr int CW_TMO = 0, CW_CODE = 1, CW_BAR = 4096;
constexpr int RING_OFF = 0, RING_BYTES = 131072;
constexpr int LDSCTL_OFF = RING_BYTES, MISC_OFF = LDSCTL_OFF + 320;
constexpr int LDS_BYTES = 147456;

struct Frame {
    LAS unsigned char* lds;
    volatile LAS unsigned* MISC;
    gu32* ctl;
    int tid, lane, wave;
    int vcu, G;
    unsigned char* ws;
};
using pg8::shx;
__device__ __forceinline__ float wave_sum(float v, int ln) {
#pragma unroll
    for (int o = 1; o < 64; o <<= 1) v += shx(v, o, ln);
    return v;
}
__device__ __forceinline__ float wave_max(float v, int ln) {
#pragma unroll
    for (int o = 1; o < 64; o <<= 1) v = fmaxf(v, shx(v, o, ln));
    return v;
}
__device__ __forceinline__ float bf2f(bf16 v) { return __uint_as_float((unsigned)v << 16); }

__device__ __forceinline__ void p0_transpose_item(const float* W, int K, int Nsrc, bf16* WT, int k0, int nsrc0, int nout0, const float* ks, LAS float* scr, int lane) {
#pragma unroll 8
    for (int i = 0; i < 32; ++i) { const int kk = 2 * i + (lane >> 5); float v = W[(size_t)(k0 + kk) * Nsrc + nsrc0 + (lane & 31)]; if (ks) v *= ks[k0 + kk]; scr[kk * 33 + (lane & 31)] = v; }
    LDS_WAIT(); asm volatile("" ::: "memory");
    const int c = lane & 7;
#pragma unroll
    for (int j = 0; j < 4; ++j) { const int n = (lane >> 3) + 8 * j; const LAS float* s = scr + (8 * c) * 33 + n;
        v4u o; o.x = pk2(s[0 * 33], s[1 * 33]); o.y = pk2(s[2 * 33], s[3 * 33]); o.z = pk2(s[4 * 33], s[5 * 33]); o.w = pk2(s[6 * 33], s[7 * 33]);
        *(GAS v4u*)(WT + (size_t)(nout0 + n) * K + k0 + 8 * c) = o; }
    LDS_WAIT(); asm volatile("" ::: "memory");
}
struct Inputs { const float* p[27]; };
__device__ __forceinline__ void p0_prologue(Frame& F, const Inputs& I) {
    LAS float* scr = (LAS float*)(F.lds + RING_OFF + F.wave * 16384);
    const int gw = F.vcu * NWAVES + F.wave, NGW = F.G * NWAVES;
    constexpr int I_IN = 16 * 72, I_OUT = 16 * 32, I_GU = 16 * 176, I_DN = 44 * 32, I_SM = 4 * 8;
    constexpr int I_LAYER = I_IN + I_OUT + I_GU + I_DN + 2 * I_SM;
    for (int it = gw; it < DEPTH * I_LAYER; it += NGW) {
        const int l = it / I_LAYER; int r = it % I_LAYER;
        unsigned char* wl = F.ws + WS_W + (size_t)l * W_LAYER;
        if (r < I_IN) { const int kb = r / 72, nb = r % 72, n0 = nb * 32; int src = n0;
            if (n0 >= 1792) { const int q = n0 - 1792, j = q >> 8, rr = q & 255; src = ((rr >> 7) ? 2048 : 1792) + 128 * j + (rr & 127); }
            p0_transpose_item(I.p[2] + (size_t)l * DM * D_IN, DM, D_IN, (bf16*)(wl + WO_IN), kb * 64, src, n0, I.p[1] + l * DM, scr, F.lane); continue; }
        r -= I_IN;
        if (r < I_OUT) { const int kb = r / 32, nb = r % 32, k0 = kb * 64;
            const float* ks = k0 < 512 ? I.p[19] + l * 512 - 0 : (k0 < 768 ? I.p[20] + l * 256 - 512 : I.p[21] + l * 256 - 768);
            p0_transpose_item(I.p[22] + (size_t)l * DM * DM, DM, DM, (bf16*)(wl + WO_OUT), k0, nb * 32, nb * 32, ks, scr, F.lane); continue; }
        r -= I_OUT;
        if (r < I_GU) { const int kb = r / 176, nb = r % 176, n0 = nb * 32; const int j = n0 >> 8, rr = n0 & 255; const int src = ((rr >> 7) ? D_FF : 0) + 128 * j + (rr & 127);
            p0_transpose_item(I.p[24] + (size_t)l * DM * D_GU, DM, D_GU, (bf16*)(wl + WO_GU), kb * 64, src, n0, I.p[23] + l * DM, scr, F.lane); continue; }
        r -= I_GU;
        if (r < I_DN) { const int kb = r / 32, nb = r % 32;
            p0_transpose_item(I.p[25] + (size_t)l * D_FF * DM, D_FF, DM, (bf16*)(wl + WO_DN), kb * 64, nb * 32, nb * 32, nullptr, scr, F.lane); continue; }
        r -= I_DN;
        if (r < I_SM) { const int kb = r / 8, nb = r % 8;
            p0_transpose_item(I.p[11] + (size_t)l * 65536, 256, 256, (bf16*)(wl + WO_GLU), kb * 64, nb * 32, nb * 32, nullptr, scr, F.lane); continue; }
        r -= I_SM;
        { const int kb = r / 8, nb = r % 8;
            p0_transpose_item(I.p[17] + (size_t)l * 65536, 256, 256, (bf16*)(wl + WO_PW2), kb * 64, nb * 32, nb * 32, nullptr, scr, F.lane); }
    }
    const float* x = I.p[0]; bf16* hb = (bf16*)(F.ws + WS_HB); float* ssq = (float*)(F.ws + WS_SSQ);
    for (int m = gw; m < M; m += NGW) {
        const GAS f32x4* xr = (const GAS f32x4*)(x + (size_t)m * DM) + F.lane; f32x4 v[4]; float s = 0.f;
#pragma unroll
        for (int j = 0; j < 4; ++j) { v[j] = xr[64 * j]; s += (v[j].x * v[j].x + v[j].y * v[j].y) + (v[j].z * v[j].z + v[j].w * v[j].w); }
        s = wave_sum(s, F.lane);
        GAS unsigned long long* o8 = (GAS unsigned long long*)(hb + (size_t)m * DM) + F.lane;
#pragma unroll
        for (int j = 0; j < 4; ++j) o8[64 * j] = (unsigned long long)pk2(v[j].x, v[j].y) | ((unsigned long long)pk2(v[j].z, v[j].w) << 32);
        if (F.lane < 16) ssq[(size_t)m * 16 + F.lane] = F.lane == 0 ? s : 0.f;
    }
    float* rope = (float*)(F.ws + WS_ROPE);
    for (int i = gw * 64 + F.lane; i < SEQ * 8; i += NGW * 64) { const int pos = i >> 3, f = i & 7;
        const float inv = powf(500000.0f, -(float)(2 * f) / 16.0f); const float ang = (float)pos * inv;
        rope[2 * i] = cosf(ang); rope[2 * i + 1] = sinf(ang); }
}

__device__ __forceinline__ void attn_naive_unit(Frame& F, int b, int h, int qb) {
    LAS float* km = (LAS float*)(F.lds);
    LAS unsigned* selm = (LAS unsigned*)(F.lds + 4096);
    LAS float* sc = (LAS float*)(F.lds + 8192) + F.wave * 1024;
    LAS float* qs = (LAS float*)(F.lds + 8192 + 8 * 4096) + F.wave * 64;
    const float* kmp = (const float*)(F.ws + WS_KMP); const float* Qf = (const float*)(F.ws + WS_QF);
    const bf16* Qb = (const bf16*)(F.ws + WS_QB); const bf16* Kb = (const bf16*)(F.ws + WS_KB); const bf16* Vb = (const bf16*)(F.ws + WS_VB); bf16* mix = (bf16*)(F.ws + WS_MIX);
    __syncthreads();
    for (int i = F.tid; i < 16 * 64; i += 512) { const int n = i >> 6, d = i & 63; float v = 0.f;
        if (n < qb) { const size_t idx = ((size_t)(b * NBLK + n) * 512) + h * 64 + d; v = (kmp[idx] + kmp[(size_t)BATCH * NBLK * 512 + idx]) * (1.0f / 256.0f); }
        km[i] = v; }
    __syncthreads();
    if (F.tid < 256) {
        const float* q = Qf + ((size_t)(b * SEQ + qb * 256 + F.tid)) * 512 + h * 64;
        float g[15];
#pragma unroll
        for (int n = 0; n < 15; ++n) g[n] = 0.f;
        for (int d4 = 0; d4 < 16; ++d4) { const f32x4 qv = *(const f32x4*)(q + 4 * d4);
#pragma unroll
            for (int n = 0; n < 15; ++n) { const LAS float* kk = km + n * 64 + 4 * d4; g[n] += (qv.x * kk[0] + qv.y * kk[1]) + (qv.z * kk[2] + qv.w * kk[3]); } }
        unsigned mask = 0u; const int topk = qb < 3 ? qb : 3;
        for (int k = 0; k < topk; ++k) { float best = -INFINITY; int bi = 0;
#pragma unroll
            for (int n = 0; n < 15; ++n) { const bool ok = n < qb && !((mask >> n) & 1u) && g[n] > best; best = ok ? g[n] : best; bi = ok ? n : bi; }
            mask |= 1u << bi; }
        selm[F.tid] = mask;
    }
    __syncthreads();
    for (int i = 0; i < 32; ++i) {
        const int t = F.wave * 32 + i, qpos = qb * 256 + t; const size_t row = (size_t)b * SEQ + qpos;
        const unsigned mask = selm[t] | (1u << qb);
        qs[F.lane] = bf2f(Qb[row * 512 + h * 64 + F.lane]);
        LDS_WAIT();
        int cnt = 0; float mx = -INFINITY;
        for (int n = 0; n <= qb; ++n) { if (!((mask >> n) & 1u)) continue;
            for (int kk = 0; kk < 4; ++kk) { const int key0 = n * 256 + kk * 64; if (key0 > qpos) break; const int key = key0 + F.lane;
                const v4u* kr = (const v4u*)(Kb + ((size_t)b * SEQ + key) * 512 + h * 64); float s = 0.f;
#pragma unroll
                for (int c = 0; c < 8; ++c) { const v4u w = kr[c]; const LAS float* qq = qs + 8 * c;
                    s += qq[0] * __uint_as_float(w.x << 16) + qq[1] * __uint_as_float(w.x & 0xffff0000u) + qq[2] * __uint_as_float(w.y << 16) + qq[3] * __uint_as_float(w.y & 0xffff0000u)
                       + qq[4] * __uint_as_float(w.z << 16) + qq[5] * __uint_as_float(w.z & 0xffff0000u) + qq[6] * __uint_as_float(w.w << 16) + qq[7] * __uint_as_float(w.w & 0xffff0000u); }
                if (key > qpos) s = -INFINITY;
                sc[cnt * 64 + F.lane] = s; mx = fmaxf(mx, s); ++cnt; } }
        mx = wave_max(mx, F.lane); float l = 0.f;
        for (int c = 0; c < cnt; ++c) { const float p = exp2f(sc[c * 64 + F.lane] - mx); sc[c * 64 + F.lane] = p; l += p; }
        l = wave_sum(l, F.lane); LDS_WAIT();
        float o = 0.f; int c = 0;
        for (int n = 0; n <= qb; ++n) { if (!((mask >> n) & 1u)) continue;
            for (int kk = 0; kk < 4; ++kk) { const int key0 = n * 256 + kk * 64; if (key0 > qpos) break;
                const bf16* vr = Vb + ((size_t)b * SEQ + key0) * 512 + h * 64 + F.lane;
#pragma unroll 8
                for (int j = 0; j < 64; ++j) o += sc[c * 64 + j] * bf2f(vr[(size_t)j * 512]);
                ++c; } }
        mix[row * DM + h * 64 + F.lane] = (bf16)f2bf(o / l);
        LDS_WAIT();
    }
}

__device__ __forceinline__ float gelu_tanh(float x) { const float u = 0.7978845608028654f * (x + 0.044715f * x * x * x); return 0.5f * x * (1.0f + tanhf(u)); }
__device__ __forceinline__ void ssm_naive_unit(Frame& F, const Inputs& I, int l, int b, int g) {
    const int p = F.lane, w = F.wave;
    LAS float* S = (LAS float*)(F.lds);
    const size_t gp = ((size_t)l * NGRP + g) * NST + p;
    const float dt = expf(I.p[5][l * NGRP + g]); const float lr = I.p[3][gp], li = I.p[4][gp];
    const float mag = expf(lr * dt); const float ar = mag * cosf(li * dt), ai = mag * sinf(li * dt);
    const float nr = ar - 1.0f, den = lr * lr + li * li; const float fr = (nr * lr + ai * li) / den, fi = (ai * lr - nr * li) / den;
    float bbr[16], bbi[16], cr[16], ci[16], dsk[16];
#pragma unroll
    for (int c = 0; c < 16; ++c) { const float br = I.p[6][gp * 16 + c], bi = I.p[7][gp * 16 + c]; bbr[c] = fr * br - fi * bi; bbi[c] = fr * bi + fi * br;
        const size_t ci_ = (((size_t)l * NGRP + g) * GCH + c) * NST + p; cr[c] = I.p[8][ci_]; ci[c] = I.p[9][ci_]; dsk[c] = I.p[10][(l * NGRP + g) * GCH + c]; }
    const bf16* Us = (const bf16*)(F.ws + WS_US); bf16* Z = (bf16*)(F.ws + WS_Z);
    const size_t row0 = (size_t)b * SEQ + w * 512;
    float hr = 0.f, hi = 0.f;
    for (int t = 0; t < 512; ++t) {
        const v4u* ur = (const v4u*)(Us + (row0 + t) * 256 + g * 16); const v4u u0 = ur[0], u1 = ur[1];
        const float uu[16] = {__uint_as_float(u0.x << 16), __uint_as_float(u0.x & 0xffff0000u), __uint_as_float(u0.y << 16), __uint_as_float(u0.y & 0xffff0000u), __uint_as_float(u0.z << 16), __uint_as_float(u0.z & 0xffff0000u), __uint_as_float(u0.w << 16), __uint_as_float(u0.w & 0xffff0000u),
                              __uint_as_float(u1.x << 16), __uint_as_float(u1.x & 0xffff0000u), __uint_as_float(u1.y << 16), __uint_as_float(u1.y & 0xffff0000u), __uint_as_float(u1.z << 16), __uint_as_float(u1.z & 0xffff0000u), __uint_as_float(u1.w << 16), __uint_as_float(u1.w & 0xffff0000u)};
        float xr = 0.f, xi = 0.f;
#pragma unroll
        for (int c = 0; c < 16; ++c) { xr += bbr[c] * uu[c]; xi += bbi[c] * uu[c]; }
        const float nr2 = ar * hr - ai * hi + xr, ni2 = ar * hi + ai * hr + xi; hr = nr2; hi = ni2;
    }
    __syncthreads();
    S[(w * 64 + p) * 2] = hr; S[(w * 64 + p) * 2 + 1] = hi;
    __syncthreads();
    float pr = ar, pi = ai;
#pragma unroll
    for (int k = 0; k < 9; ++k) { const float t0 = pr * pr - pi * pi, t1 = 2.0f * pr * pi; pr = t0; pi = t1; }
    hr = 0.f; hi = 0.f;
    for (int j = 0; j < w; ++j) { const float sr = S[(j * 64 + p) * 2], si = S[(j * 64 + p) * 2 + 1]; const float t0 = pr * hr - pi * hi + sr, t1 = pr * hi + pi * hr + si; hr = t0; hi = t1; }
    for (int t = 0; t < 512; ++t) {
        const v4u* ur = (const v4u*)(Us + (row0 + t) * 256 + g * 16); const v4u u0 = ur[0], u1 = ur[1];
        const float uu[16] = {__uint_as_float(u0.x << 16), __uint_as_float(u0.x & 0xffff0000u), __uint_as_float(u0.y << 16), __uint_as_float(u0.y & 0xffff0000u), __uint_as_float(u0.z << 16), __uint_as_float(u0.z & 0xffff0000u), __uint_as_float(u0.w << 16), __uint_as_float(u0.w & 0xffff0000u),
                              __uint_as_float(u1.x << 16), __uint_as_float(u1.x & 0xffff0000u), __uint_as_float(u1.y << 16), __uint_as_float(u1.y & 0xffff0000u), __uint_as_float(u1.z << 16), __uint_as_float(u1.z & 0xffff0000u), __uint_as_float(u1.w << 16), __uint_as_float(u1.w & 0xffff0000u)};
        float xr = 0.f, xi = 0.f;
#pragma unroll
        for (int c = 0; c < 16; ++c) { xr += bbr[c] * uu[c]; xi += bbi[c] * uu[c]; }
        const float nr2 = ar * hr - ai * hi + xr, ni2 = ar * hi + ai * hr + xi; hr = nr2; hi = ni2;
        float v[16];
#pragma unroll
        for (int c = 0; c < 16; ++c) v[c] = cr[c] * hr - ci[c] * hi;
        float v8[8], v4[4], v2[2], v1;
        { const bool up = (p & 32) != 0;
#pragma unroll
          for (int c = 0; c < 8; ++c) { const float keep = up ? v[c + 8] : v[c], send = up ? v[c] : v[c + 8]; v8[c] = keep + shx(send, 32, p); } }
        { const bool up = (p & 16) != 0;
#pragma unroll
          for (int c = 0; c < 4; ++c) { const float keep = up ? v8[c + 4] : v8[c], send = up ? v8[c] : v8[c + 4]; v4[c] = keep + shx(send, 16, p); } }
        { const bool up = (p & 8) != 0;
#pragma unroll
          for (int c = 0; c < 2; ++c) { const float keep = up ? v4[c + 2] : v4[c], send = up ? v4[c] : v4[c + 2]; v2[c] = keep + shx(send, 8, p); } }
        { const bool up = (p & 4) != 0; const float keep = up ? v2[1] : v2[0], send = up ? v2[0] : v2[1]; v1 = keep + shx(send, 4, p); }
        v1 += shx(v1, 2, p); v1 += shx(v1, 1, p);
        const int c = ((p >> 5) & 1) * 8 + ((p >> 4) & 1) * 4 + ((p >> 3) & 1) * 2 + ((p >> 2) & 1);
        float uc = uu[0], dc = dsk[0];
#pragma unroll
        for (int k = 1; k < 16; ++k) { uc = (c == k) ? uu[k] : uc; dc = (c == k) ? dsk[k] : dc; }
        const float y = v1 + dc * uc;
        if ((p & 3) == 0) Z[(row0 + t) * 256 + g * 16 + c] = (bf16)f2bf(gelu_tanh(y));
    }
}

__device__ __forceinline__ void conv_pre_token(Frame& F, const Inputs& I, int l, int row) {
    const bf16* Uc = (const bf16*)(F.ws + WS_UC); bf16* Yc = (bf16*)(F.ws + WS_YC);
    const int t = row & (SEQ - 1), c0 = 4 * F.lane;
    const float* cw = I.p[13] + (size_t)l * CWID * 256 + c0;
    f32x4 a = *(const f32x4*)(I.p[14] + l * 256 + c0);
    for (int j = 0; j < CWID; ++j) { const int tt = t - (CWID - 1) + j; if (tt < 0) continue;
        const unsigned long long uw = *(const unsigned long long*)(Uc + (size_t)(row - (CWID - 1) + j) * 256 + c0); const f32x4 w = *(const f32x4*)(cw + (size_t)j * 256);
        a.x += w.x * __uint_as_float((unsigned)uw << 16); a.y += w.y * __uint_as_float((unsigned)uw & 0xffff0000u);
        a.z += w.z * __uint_as_float((unsigned)(uw >> 32) << 16); a.w += w.w * __uint_as_float((unsigned)(uw >> 32) & 0xffff0000u); }
    const float mu = wave_sum((a.x + a.y) + (a.z + a.w), F.lane) * (1.0f / 256.0f);
    a = a - mu;
    const float var = wave_sum((a.x * a.x + a.y * a.y) + (a.z * a.z + a.w * a.w), F.lane) * (1.0f / 256.0f);
    const float rs = 1.0f / sqrtf(var + LN_EPS);
    const f32x4 g = *(const f32x4*)(I.p[15] + l * 256 + c0), bb = *(const f32x4*)(I.p[16] + l * 256 + c0);
    f32x4 y = a * rs * g + bb;
    y.x = y.x / (1.0f + __expf(-y.x)); y.y = y.y / (1.0f + __expf(-y.y)); y.z = y.z / (1.0f + __expf(-y.z)); y.w = y.w / (1.0f + __expf(-y.w));
    *(unsigned long long*)(Yc + (size_t)row * 256 + c0) = (unsigned long long)pk2(y.x, y.y) | ((unsigned long long)pk2(y.z, y.w) << 32);
}
__device__ __forceinline__ void attn_norm_row(Frame& F, int row) {
    bf16* mix = (bf16*)(F.ws + WS_MIX) + (size_t)row * DM + 8 * F.lane;
    const v4u w = *(const v4u*)mix;
    float v[8] = {__uint_as_float(w.x << 16), __uint_as_float(w.x & 0xffff0000u), __uint_as_float(w.y << 16), __uint_as_float(w.y & 0xffff0000u), __uint_as_float(w.z << 16), __uint_as_float(w.z & 0xffff0000u), __uint_as_float(w.w << 16), __uint_as_float(w.w & 0xffff0000u)};
    float s = 0.f;
#pragma unroll
    for (int k = 0; k < 8; ++k) s += v[k] * v[k];
    const float rs = 1.0f / sqrtf(wave_sum(s, F.lane) * (1.0f / 512.0f) + RMS_EPS);
    v4u o; o.x = pk2(v[0] * rs, v[1] * rs); o.y = pk2(v[2] * rs, v[3] * rs); o.z = pk2(v[4] * rs, v[5] * rs); o.w = pk2(v[6] * rs, v[7] * rs);
    *(v4u*)mix = o;
}
__device__ __forceinline__ void final_norm_row(Frame& F, float* out, const float* gain, int row) {
    GAS f32x4* xr = (GAS f32x4*)(out + (size_t)row * DM) + F.lane; f32x4 v[4]; float s = 0.f;
#pragma unroll
    for (int j = 0; j < 4; ++j) { v[j] = xr[64 * j]; s += (v[j].x * v[j].x + v[j].y * v[j].y) + (v[j].z * v[j].z + v[j].w * v[j].w); }
    const float rs = 1.0f / sqrtf(wave_sum(s, F.lane) * (1.0f / DM) + RMS_EPS);
#pragma unroll
    for (int j = 0; j < 4; ++j) { const f32x4 gg = *((const f32x4*)gain + F.lane + 64 * j); xr[64 * j] = v[j] * rs * gg; }
}


constexpr int KM_OFF = 86016;
static_assert(attn_body::ATTN_LDS_BYTES <= KM_OFF && KM_OFF + 4096 <= RING_BYTES, "attention LDS map");
__device__ __forceinline__ unsigned moba_gate(Frame& F, unsigned char* wsu, int b, int h, int qb) {
    LAS float* km = (LAS float*)(F.lds + KM_OFF);
    int tid = threadIdx.x; asm volatile("" : "+v"(tid)); const int lane = tid & 63;
    const float* kmp = (const float*)(wsu + WS_KMP); const float* Qf = (const float*)(wsu + WS_QF);
    for (int i = tid; i < 16 * 64; i += 512) { const int n = i >> 6, d = i & 63; float v = 0.f;
        if (n < qb) { const size_t idx = ((size_t)(b * NBLK + n) * 512) + h * 64 + d; v = (kmp[idx] + kmp[(size_t)BATCH * NBLK * 512 + idx]) * (1.0f / 256.0f); }
        km[i] = v; }
    __syncthreads();
    const int r32 = lane & 31, hi = lane >> 5;
    const float* q = Qf + ((size_t)b * SEQ + qb * 256 + F.wave * 32 + r32) * 512 + h * 64 + hi * 32;
    float g[15];
#pragma unroll
    for (int n = 0; n < 15; ++n) g[n] = 0.f;
#pragma unroll 2
    for (int d4 = 0; d4 < 8; ++d4) { const f32x4 qv = *(const f32x4*)(q + 4 * d4);
#pragma unroll
        for (int n = 0; n < 15; ++n) { const LAS float* kk = km + n * 64 + hi * 32 + 4 * d4; g[n] += (qv.x * kk[0] + qv.y * kk[1]) + (qv.z * kk[2] + qv.w * kk[3]); } }
#pragma unroll
    for (int n = 0; n < 15; ++n) g[n] += shx(g[n], 32, lane);
    unsigned mask = 0u; const int topk = qb < 3 ? qb : 3;
    for (int k = 0; k < topk; ++k) { float best = -INFINITY; int bi = 0;
#pragma unroll
        for (int n = 0; n < 15; ++n) { const bool ok = n < qb && !((mask >> n) & 1u) && g[n] > best; best = ok ? g[n] : best; bi = ok ? n : bi; }
        mask |= 1u << bi; }
    return mask;
}

struct Args { Inputs in; float* out; unsigned char* ws; int ph_lo, ph_hi, li, pad; };
template <int PHM> __global__ void __launch_bounds__(NWAVES * 64, 2) skel_fwd(Args args) {
    extern __shared__ __attribute__((aligned(16))) unsigned char lds[];
#define FRAME() Frame F; { unsigned char* ws_ = args.ws; int t_ = threadIdx.x; asm volatile("" : "+s"(ws_), "+v"(t_)); F.lds = (LAS unsigned char*)lds; F.MISC = (volatile LAS unsigned*)(F.lds + MISC_OFF); \
        F.tid = t_; F.lane = t_ & 63; F.wave = __builtin_amdgcn_readfirstlane(t_ >> 6); F.G = gridDim.x; { const int bx = blockIdx.x; F.vcu = (F.G % 8 == 0) ? (bx % 8) * (F.G / 8) + bx / 8 : bx; } \
        F.ws = ws_; F.ctl = (gu32*)(ws_ + WS_CTL); } \
        bf16* const HB = (bf16*)(F.ws + WS_HB); float* const SSQ = (float*)(F.ws + WS_SSQ); bf16* const MIX = (bf16*)(F.ws + WS_MIX); const int gw = F.vcu * NWAVES + F.wave, NGW = F.G * NWAVES; (void)HB; (void)SSQ; (void)MIX; (void)gw; (void)NGW;
    LAS unsigned char* const lds0 = (LAS unsigned char*)lds;
    gu32* const ctl0 = (gu32*)(args.ws + WS_CTL);
    const Inputs& I = args.in;
    for (int u = threadIdx.x; u < (LDS_BYTES - LDSCTL_OFF) / 4; u += NWAVES * 64) ((LAS unsigned*)(lds0 + LDSCTL_OFF))[u] = 0u;
    __syncthreads();
    XcdBarrier bar; bar.bar = (unsigned*)(ctl0 + CW_BAR); bar.x = 0; bar.st = nullptr;
    if (MK_ONE_LAUNCH) bar = xcd_barrier_post((unsigned*)(ctl0 + CW_BAR), (volatile LAS unsigned*)(lds0 + MISC_OFF) + 8);
#define GRID_BAR() do { if (MK_ONE_LAUNCH) xcd_barrier(bar); } while (0)
    const int lo = args.ph_lo, hi = args.ph_hi;
#define PHON(t) (((PHM) >> (t)) & 1)
#define IN(k) (lo <= (k) && (k) < hi)
#define BOTH(k) (IN(k) && IN((k) + 1))

    if (PHON(0) && IN(0)) { FRAME(); p0_prologue(F, I); if (BOTH(0)) GRID_BAR(); }

    for (int l = 0; l < DEPTH; ++l) {
        const int pb = 1 + 6 * l;
#define WL() unsigned char* wl = F.ws + WS_W + (size_t)l * W_LAYER;
        if (PHON(1) && IN(pb)) { FRAME(); WL(); (void)wl;
            pg8::Gemm g{HB, (const bf16*)(wl + WO_IN), M, D_IN, DM}; pg8::StaticOrder S; S.init(M, D_IN, F.G, (int)blockIdx.x);
            pg8::EpiInProj E{SSQ, (const float*)(F.ws + WS_ROPE), (bf16*)(F.ws + WS_QB), (bf16*)(F.ws + WS_KB), (bf16*)(F.ws + WS_VB), (bf16*)(F.ws + WS_US), (bf16*)(F.ws + WS_UC), (float*)(F.ws + WS_QF), (float*)(F.ws + WS_KMP)};
            pg8::gemm_phase<pg8::EpiInProj, pg8::StaticOrder, true, true>(F.lds + RING_OFF, g, S, E);
            if (BOTH(pb)) GRID_BAR();
        }
        if (PHON(2) && IN(pb + 1)) { FRAME(); WL(); (void)wl;
            if (F.vcu < BATCH * NGRP) { ssm_naive_unit(F, I, l, F.vcu / NGRP, F.vcu % NGRP); }
            else { const int nw = (F.G - BATCH * NGRP) * NWAVES, w0 = (F.vcu - BATCH * NGRP) * NWAVES + F.wave; if (nw > 0) for (int r = w0; r < M; r += nw) conv_pre_token(F, I, l, r); }
            if (F.G <= BATCH * NGRP) { for (int r = gw; r < M; r += NGW) conv_pre_token(F, I, l, r); }
            for (int i = F.vcu; i < BATCH * NHEAD * NBLK; i += F.G) {
                const int j = i >> 8, v = i & 255, bh = v >> 2, c = v & 3, k = (j & 1) + 2 * c + 8 * (j >> 1); const int qb = (k & 1) ? 15 - (k >> 1) : (k >> 1);
#if ATTN_NAIVE
                attn_naive_unit(F, bh >> 3, bh & 7, qb);
#else
                { unsigned char* wsu = args.ws; asm volatile("" : "+s"(wsu));
                  const unsigned selbits = moba_gate(F, wsu, bh >> 3, bh & 7, qb);
                  attn_body::attn_unit<8>(bh >> 3, bh & 7, qb, selbits, (const attn_body::bf16*)(wsu + WS_QB), (const attn_body::bf16*)(wsu + WS_KB), (const attn_body::bf16*)(wsu + WS_VB), (attn_body::bf16*)(wsu + WS_MIX), (char*)lds + RING_OFF); }
#endif
            }
            if (BOTH(pb + 1)) GRID_BAR();
        }
        if (PHON(3) && IN(pb + 2)) { FRAME(); WL(); (void)wl;
            for (int r = gw; r < M; r += NGW) attn_norm_row(F, r);
            int K256 = 256; asm volatile("" : "+s"(K256));
            for (int i = F.vcu; i < 256; i += F.G) {
#ifndef TAIL_SKIP0
                if (i < 128) { pg8::Gemm g{(const bf16*)(F.ws + WS_Z), (const bf16*)(wl + WO_GLU), M, 256, K256}; pg8::OneUnit S{i, true};
                    pg8::EpiRowNorm<0> E{(const bf16*)(F.ws + WS_Z), I.p[12] + l * 256, MIX, 512};
                    pg8::gemm_phase<pg8::EpiRowNorm<0>, pg8::OneUnit, false, true>(F.lds + RING_OFF, g, S, E); }
#endif
#ifndef TAIL_SKIP1
                if (i >= 128) { pg8::Gemm g{(const bf16*)(F.ws + WS_YC), (const bf16*)(wl + WO_PW2), M, 256, K256}; pg8::OneUnit S{i - 128, true};
                    pg8::EpiRowNorm<1> E{nullptr, I.p[18] + l * 256, MIX, 768};
                    pg8::gemm_phase<pg8::EpiRowNorm<1>, pg8::OneUnit, false, true>(F.lds + RING_OFF, g, S, E); }
#endif
            }
            if (BOTH(pb + 2)) GRID_BAR();
        }
        if (PHON(4) && IN(pb + 3)) { FRAME(); WL(); (void)wl;
            pg8::Gemm g{MIX, (const bf16*)(wl + WO_OUT), M, DM, DM}; pg8::StaticOrder S; S.init(M, DM, F.G, (int)blockIdx.x);
            pg8::EpiResid E{l == 0 ? I.p[0] : args.out, args.out, HB, SSQ};
            pg8::gemm_phase<pg8::EpiResid, pg8::StaticOrder, true, true>(F.lds + RING_OFF, g, S, E);
            if (BOTH(pb + 3)) GRID_BAR();
        }
        if (PHON(5) && IN(pb + 4)) { FRAME(); WL(); (void)wl;
            pg8::Gemm g{HB, (const bf16*)(wl + WO_GU), M, D_GU, DM}; pg8::StaticOrder S; S.init(M, D_GU, F.G, (int)blockIdx.x);
            pg8::EpiSwiGlu E{SSQ, (bf16*)(F.ws + WS_ACT)};
            pg8::gemm_phase<pg8::EpiSwiGlu, pg8::StaticOrder, true, true>(F.lds + RING_OFF, g, S, E);
            if (BOTH(pb + 4)) GRID_BAR();
        }
        if (PHON(6) && IN(pb + 5)) { FRAME(); WL(); (void)wl;
            pg8::Gemm g{(const bf16*)(F.ws + WS_ACT), (const bf16*)(wl + WO_DN), M, DM, D_FF}; pg8::StaticOrder S; S.init(M, DM, F.G, (int)blockIdx.x);
            pg8::EpiResid E{args.out, args.out, HB, SSQ};
            pg8::gemm_phase<pg8::EpiResid, pg8::StaticOrder, true, true>(F.lds + RING_OFF, g, S, E);
            if (BOTH(pb + 5)) GRID_BAR();
        }
    }
    if (PHON(7) && IN(13)) { FRAME(); for (int r = gw; r < M; r += NGW) final_norm_row(F, args.out, I.p[26], r); }
#undef IN
#undef BOTH
}

typedef void (*kern_t)(Args);
static int phase_type(int p) { return p == 0 ? 0 : (p == 13 ? 7 : 1 + (p - 1) % 6); }
extern "C" void kernel_launch(void* const* d_in, const int* in_sizes, int n_in, void* d_out, int out_size, void* d_ws, size_t ws_size, hipStream_t stream) {
    static int grid = 0;
#if MK_ONE_LAUNCH
    static const kern_t kerns[1] = {skel_fwd<0xff>}; constexpr int NK = 1;
#else
    static const kern_t kerns[8] = {skel_fwd<0x01>, skel_fwd<0x02>, skel_fwd<0x04>, skel_fwd<0x08>, skel_fwd<0x10>, skel_fwd<0x20>, skel_fwd<0x40>, skel_fwd<0x80>}; constexpr int NK = 8;
#endif
    if (grid == 0) {
        if (n_in != 27 || out_size != M * DM || ws_size < WS_END) { fprintf(stderr, "kernel_launch: unexpected shapes: n_in %d out %d ws %zu\n", n_in, out_size, ws_size); grid = -1; return; }
        int dev = 0, cus = 0;
        if (hipGetDevice(&dev) != hipSuccess || hipDeviceGetAttribute(&cus, hipDeviceAttributeMultiprocessorCount, dev) != hipSuccess) { grid = -1; return; }
        for (int k = 0; k < NK; ++k) if (hipFuncSetAttribute((const void*)kerns[k], hipFuncAttributeMaxDynamicSharedMemorySize, LDS_BYTES) != hipSuccess) { fprintf(stderr, "kernel_launch: hipFuncSetAttribute failed\n"); grid = -1; return; }
        (void)hipGetLastError();
        grid = cus;
    }
    if (grid < 0) return;
    if (hipMemsetAsync((char*)d_ws + WS_CTL, 0, CTL_ZERO_BYTES, stream) != hipSuccess) return;
    Args a{};
    for (int i = 0; i < 27; ++i) a.in.p[i] = (const float*)d_in[i];
    a.out = (float*)d_out; a.ws = (unsigned char*)d_ws;
#if MK_ONE_LAUNCH
    a.ph_lo = 0; a.ph_hi = N_PHASES; a.li = 0; hipLaunchKernelGGL(kerns[0], dim3(grid), dim3(NWAVES * 64), LDS_BYTES, stream, a);
#else
    for (int p = 0; p < N_PHASES; ++p) { a.ph_lo = p; a.ph_hi = p + 1; a.li = p; hipLaunchKernelGGL(kerns[phase_type(p)], dim3(grid), dim3(NWAVES * 64), LDS_BYTES, stream, a); }
#endif
}
```

```cpp
#include <hip/hip_runtime.h>
#include <cstdio>
#include <cstdint>
namespace pg8 {
#define PG8_LAS __attribute__((address_space(3)))
typedef unsigned short bf16_t;
typedef short bf16x8 __attribute__((ext_vector_type(8)));
typedef float f32x4 __attribute__((ext_vector_type(4)));
typedef unsigned u32x4 __attribute__((ext_vector_type(4)));
constexpr int BM = 256, BK = 64, HALF = 128, HTB = HALF * BK * 2  , STAGE_BYTES = 8 * HTB, NXCD = 8, WGM = 8;

__host__ __device__ __forceinline__ int lds_byte(int r, int c) { const int st = (r >> 4) * 2 + (c >> 5), rr = r & 15, cc = c & 31, ob = rr * 64 + cc * 2; return st * 1024 + (ob ^ (((ob >> 9) & 1) << 5)); }
__host__ __device__ __forceinline__ void stage_rc(int b, int& R, int& C) { const int st = b / 1024, sb = b % 1024, swz = sb ^ (((sb >> 9) & 1) << 5); R = (st >> 1) * 16 + swz / 64; C = (st & 1) * 32 + (swz % 64) / 2; }
__host__ __device__ __forceinline__ int perm32(int rho) { const int n = rho >> 4, i = rho & 15; return 8 * (i >> 2) + 4 * n + (i & 3); }

struct Unit { int pm, pn; };
struct Gemm { const bf16_t* A; const bf16_t* Bt; int M, N, K; };

struct StaticOrder {
    int nM, nN, nwg, G, c;
    __host__ __device__ void init(int M, int N, int G_, int c_) { nM = M / BM; nN = N / BM; nwg = nM * nN; G = G_; c = c_; }
    __host__ __device__ bool next(int i, Unit& u) const {
        const long L = (long)i * G + c; if (L >= nwg) return false;
        int wgid = (int)L; { const int q = nwg / NXCD, r = nwg % NXCD, xcd = wgid % NXCD, off = wgid / NXCD; wgid = (xcd < r ? xcd * (q + 1) : r * (q + 1) + (xcd - r) * q) + off; }
        const int nig = WGM * nN, gid = wgid / nig, fm = gid * WGM, gsz = (nM - fm) < WGM ? (nM - fm) : WGM;
        u.pm = fm + ((wgid % nig) % gsz); u.pn = (wgid % nig) / gsz; return true;
    }
    __device__ __forceinline__ void a_ready(const Unit&) const {}
    __device__ __forceinline__ void done(const Unit&) const {}
};

__device__ __forceinline__ unsigned cvt_pk_bf16(float lo, float hi) { unsigned r; asm volatile("v_cvt_pk_bf16_f32 %0, %1, %2" : "=v"(r) : "v"(lo), "v"(hi)); return r; }
typedef float f32x2 __attribute__((ext_vector_type(2)));
}

namespace mdl {
constexpr int BATCH = 8, SEQ = 4096, DM = 1024, M = BATCH * SEQ, DEPTH = 2;
constexpr int D_ATTN = 512, NHEAD = 8, HD = 64, D_SSM = 256, D_CONV = 256, NGRP = 16, GCH = 16, NST = 64, CWID = 31;
constexpr int D_IN = 2304, D_FF = 2816, D_GU = 5632, NBLK = SEQ / 256;
constexpr float RMS_EPS = 1e-6f, LN_EPS = 1e-5f;
constexpr float C2 = 0.125f * 1.4426950408889634f;
}

namespace pg8 {
typedef unsigned u32x2 __attribute__((ext_vector_type(2)));
__device__ __forceinline__ float shx(float v, int m, int lane) { return __builtin_bit_cast(float, __builtin_amdgcn_ds_bpermute((lane ^ m) << 2, __builtin_bit_cast(int, v))); }
__device__ __forceinline__ float row_rstd16(const float* ssq, int row, float inv_n, float eps) {
    const f32x4* p = (const f32x4*)(ssq + (size_t)row * 16); const f32x4 a = p[0], b = p[1], c = p[2], d = p[3];
    const float s = ((a[0] + a[1]) + (a[2] + a[3])) + ((b[0] + b[1]) + (b[2] + b[3])) + ((c[0] + c[1]) + (c[2] + c[3])) + ((d[0] + d[1]) + (d[2] + d[3]));
    return 1.0f / sqrtf(s * inv_n + eps);
}
__device__ __forceinline__ float sigmoidf_(float x) { return 1.0f / (1.0f + __expf(-x)); }

struct EpiInProj {
    static constexpr bool PERM = true, AFTER_DRAIN = false;
    const float* ssq; const float* rope; bf16_t *Qb, *Kb, *Vb, *Us, *Uc; float* Qf; float* kmp;
    __device__ __forceinline__ void operator()(const f32x4 (&acc)[2][2][4][2], const Unit& u, int wr, int wc, int fr, int fq) const {
        asm volatile("" : "+v"(fr), "+v"(fq)); const int ln = fq * 16 + fr;
        const int pn = u.pn, rowb = u.pm * BM + wr * 64 + fr, lcol = wc * 32 + fq * 8;
        const bool isq = pn < 2, isk = (pn == 2 || pn == 3);
        if (isq || isk) {
            const bool rotw = (wc & 1) == 0;
            const bool rot = rotw && fq < 2; const float sgn = fq == 0 ? -1.f : 1.f;
            f32x4 cs[2][2];
#pragma unroll
            for (int bj = 0; bj < 2; ++bj)
#pragma unroll
                for (int n = 0; n < 2; ++n) cs[bj][n] = (f32x4){0.f, 0.f, 0.f, 0.f};
            bf16_t* O = isq ? Qb : Kb; const int ct = isq ? pn : pn - 2;
#pragma unroll
            for (int ai = 0; ai < 2; ++ai)
#pragma unroll
                for (int m = 0; m < 4; ++m) {
                    const int row = rowb + ai * HALF + m * 16; const float rs = row_rstd16(ssq, row, 1.0f / 1024.0f, mdl::RMS_EPS);
                    f32x4 v[2][2];
#pragma unroll
                    for (int bj = 0; bj < 2; ++bj)
#pragma unroll
                        for (int n = 0; n < 2; ++n) v[bj][n] = acc[ai][bj][m][n] * rs;
                    if (rotw) {
                        const f32x4* rp = (const f32x4*)(rope + (size_t)(row & (mdl::SEQ - 1)) * 16);
                        const f32x4 r0 = rp[0], r1 = rp[1], r2 = rp[2], r3 = rp[3];
                        const float cc[2][4] = {{r0[0], r0[2], r1[0], r1[2]}, {r2[0], r2[2], r3[0], r3[2]}}, ss[2][4] = {{r0[1], r0[3], r1[1], r1[3]}, {r2[1], r2[3], r3[1], r3[3]}};
#pragma unroll
                        for (int bj = 0; bj < 2; ++bj)
#pragma unroll
                            for (int n = 0; n < 2; ++n)
#pragma unroll
                                for (int i = 0; i < 4; ++i) { const float x = v[bj][n][i], p = shx(x, 16, ln); if (rot) v[bj][n][i] = x * cc[n][i] + sgn * p * ss[n][i]; }
                    }
#pragma unroll
                    for (int bj = 0; bj < 2; ++bj) {
                        const size_t off = (size_t)row * 512 + ct * 256 + bj * HALF + lcol;
                        const float sc = isq ? mdl::C2 : 1.0f;
                        u32x4 w; w.x = cvt_pk_bf16(v[bj][0][0] * sc, v[bj][0][1] * sc); w.y = cvt_pk_bf16(v[bj][0][2] * sc, v[bj][0][3] * sc); w.z = cvt_pk_bf16(v[bj][1][0] * sc, v[bj][1][1] * sc); w.w = cvt_pk_bf16(v[bj][1][2] * sc, v[bj][1][3] * sc);
                        *(u32x4*)(O + off) = w;
                        if (isq) { *(f32x4*)(Qf + off) = v[bj][0]; *(f32x4*)(Qf + off + 4) = v[bj][1]; }
                        else { cs[bj][0] += v[bj][0]; cs[bj][1] += v[bj][1]; }
                    }
                }
            if (isk) {
#pragma unroll
                for (int bj = 0; bj < 2; ++bj)
#pragma unroll
                    for (int n = 0; n < 2; ++n)
#pragma unroll
                        for (int i = 0; i < 4; ++i) { float s = cs[bj][n][i]; s += shx(s, 1, ln); s += shx(s, 2, ln); s += shx(s, 4, ln); s += shx(s, 8, ln); cs[bj][n][i] = s; }
                if (fr == 0) {
                    float* kp = kmp + ((size_t)(wr * mdl::BATCH * mdl::NBLK + u.pm) * 512) + ct * 256 + lcol;
#pragma unroll
                    for (int bj = 0; bj < 2; ++bj) { *(f32x4*)(kp + bj * HALF) = cs[bj][0]; *(f32x4*)(kp + bj * HALF + 4) = cs[bj][1]; }
                }
            }
        } else if (pn < 7) {
            bf16_t* O = pn == 6 ? Us : Vb; const int ld = pn == 6 ? 256 : 512, ct = pn == 6 ? 0 : pn - 4;
#pragma unroll
            for (int ai = 0; ai < 2; ++ai)
#pragma unroll
                for (int m = 0; m < 4; ++m) {
                    const int row = rowb + ai * HALF + m * 16; const float rs = row_rstd16(ssq, row, 1.0f / 1024.0f, mdl::RMS_EPS);
#pragma unroll
                    for (int bj = 0; bj < 2; ++bj) { const f32x4 v0 = acc[ai][bj][m][0] * rs, v1 = acc[ai][bj][m][1] * rs;
                        u32x4 w; w.x = cvt_pk_bf16(v0[0], v0[1]); w.y = cvt_pk_bf16(v0[2], v0[3]); w.z = cvt_pk_bf16(v1[0], v1[1]); w.w = cvt_pk_bf16(v1[2], v1[3]);
                        *(u32x4*)(O + (size_t)row * ld + ct * 256 + bj * HALF + lcol) = w; }
                }
        } else {
            const int ct = pn - 7;
#pragma unroll
            for (int ai = 0; ai < 2; ++ai)
#pragma unroll
                for (int m = 0; m < 4; ++m) {
                    const int row = rowb + ai * HALF + m * 16; const float rs = row_rstd16(ssq, row, 1.0f / 1024.0f, mdl::RMS_EPS);
                    float o[8];
#pragma unroll
                    for (int n = 0; n < 2; ++n)
#pragma unroll
                        for (int i = 0; i < 4; ++i) { const float a = acc[ai][0][m][n][i] * rs, g = acc[ai][1][m][n][i] * rs; o[n * 4 + i] = a * sigmoidf_(g); }
                    u32x4 w; w.x = cvt_pk_bf16(o[0], o[1]); w.y = cvt_pk_bf16(o[2], o[3]); w.z = cvt_pk_bf16(o[4], o[5]); w.w = cvt_pk_bf16(o[6], o[7]);
                    *(u32x4*)(Uc + (size_t)row * 256 + ct * HALF + lcol) = w;
                }
        }
    }
};

struct EpiResid {
    static constexpr bool PERM = true, AFTER_DRAIN = false;
    bf16_t* hb; float* ssq;
    __device__ __forceinline__ void operator()(const f32x4 (&acc)[2][2][4][2], const Unit& u, int wr, int wc, int fr, int fq) const {
        asm volatile("" : "+v"(fr), "+v"(fq)); const int ln = fq * 16 + fr;
        const int col0 = u.pn * BM + wc * 32 + 8 * fq;
#pragma unroll
        for (int ai = 0; ai < 2; ++ai)
#pragma unroll
            for (int m = 0; m < 4; ++m) {
                const int row = u.pm * BM + ai * HALF + wr * 64 + m * 16 + fr; bf16_t* hp = hb + (size_t)row * mdl::DM + col0; float s = 0.f;
#pragma unroll
                for (int bj = 0; bj < 2; ++bj) {
                    const u32x4 b = *(const u32x4*)(hp + bj * HALF);
                    const f32x4 o0 = acc[ai][bj][m][0] + (f32x4){__uint_as_float(b.x << 16), __uint_as_float(b.x & 0xffff0000u), __uint_as_float(b.y << 16), __uint_as_float(b.y & 0xffff0000u)};
                    const f32x4 o1 = acc[ai][bj][m][1] + (f32x4){__uint_as_float(b.z << 16), __uint_as_float(b.z & 0xffff0000u), __uint_as_float(b.w << 16), __uint_as_float(b.w & 0xffff0000u)};
                    s += (o0[0] * o0[0] + o0[1] * o0[1]) + (o0[2] * o0[2] + o0[3] * o0[3]) + (o1[0] * o1[0] + o1[1] * o1[1]) + (o1[2] * o1[2] + o1[3] * o1[3]);
                    u32x4 w; w.x = cvt_pk_bf16(o0[0], o0[1]); w.y = cvt_pk_bf16(o0[2], o0[3]); w.z = cvt_pk_bf16(o1[0], o1[1]); w.w = cvt_pk_bf16(o1[2], o1[3]);
                    *(u32x4*)(hp + bj * HALF) = w; }
                s += shx(s, 16, ln); s += shx(s, 32, ln);
                if (fq == 0) ssq[(size_t)row * 16 + u.pn * 4 + wc] = s;
                if (m & 1) asm volatile("" ::: "memory");
            }
    }
};

struct EpiSwiGlu {
    static constexpr bool PERM = true, AFTER_DRAIN = false;
    const float* ssq; bf16_t* act;
    __device__ __forceinline__ void operator()(const f32x4 (&acc)[2][2][4][2], const Unit& u, int wr, int wc, int fr, int fq) const {
        asm volatile("" : "+v"(fr), "+v"(fq)); const int ln = fq * 16 + fr;
        const int col0 = u.pn * HALF + wc * 32 + fq * 8;
#pragma unroll
        for (int ai = 0; ai < 2; ++ai)
#pragma unroll
            for (int m = 0; m < 4; ++m) {
                const int row = u.pm * BM + ai * HALF + wr * 64 + m * 16 + fr; const float rs = row_rstd16(ssq, row, 1.0f / 1024.0f, mdl::RMS_EPS);
                float o[8];
#pragma unroll
                for (int n = 0; n < 2; ++n)
#pragma unroll
                    for (int i = 0; i < 4; ++i) { const float g = acc[ai][0][m][n][i] * rs, up = acc[ai][1][m][n][i] * rs; o[n * 4 + i] = g * sigmoidf_(g) * up; }
                u32x4 w; w.x = cvt_pk_bf16(o[0], o[1]); w.y = cvt_pk_bf16(o[2], o[3]); w.z = cvt_pk_bf16(o[4], o[5]); w.w = cvt_pk_bf16(o[6], o[7]);
                *(u32x4*)(act + (size_t)row * mdl::D_FF + col0) = w;
            }
    }
};

template <int MODE> struct EpiRowNorm {
    static constexpr bool PERM = true, AFTER_DRAIN = true;
    const bf16_t* z; const float* bias; bf16_t* out; int ocol;
    __device__ __forceinline__ void fused(f32x4 (&acc)[2][2][4][2], const Unit& u, int wr, int wc, int fr, int fq, PG8_LAS unsigned char* lds, int wid, int lane) const {
        asm volatile("" : "+v"(fr), "+v"(fq)); const int ln = fq * 16 + fr;
        PG8_LAS float* P = (PG8_LAS float*)lds;
        const int lcol = wc * 32 + fq * 8;
        f32x4 bv[2][2];
#pragma unroll
        for (int bj = 0; bj < 2; ++bj)
#pragma unroll
            for (int n = 0; n < 2; ++n) bv[bj][n] = *(const f32x4*)(bias + bj * HALF + lcol + 4 * n);
#pragma unroll
        for (int ai = 0; ai < 2; ++ai)
#pragma unroll
            for (int m = 0; m < 4; ++m) {
                const int lrow = ai * HALF + wr * 64 + m * 16 + fr, row = u.pm * BM + lrow; float s = 0.f;
#pragma unroll
                for (int bj = 0; bj < 2; ++bj) {
                    f32x4 v0 = acc[ai][bj][m][0] + bv[bj][0], v1 = acc[ai][bj][m][1] + bv[bj][1];
                    if (MODE == 0) {
                        const u32x4 zz = *(const u32x4*)(z + (size_t)row * 256 + bj * HALF + lcol);
                        const float z0 = __uint_as_float(zz.x << 16), z1 = __uint_as_float(zz.x & 0xffff0000u), z2 = __uint_as_float(zz.y << 16), z3 = __uint_as_float(zz.y & 0xffff0000u);
                        const float z4 = __uint_as_float(zz.z << 16), z5 = __uint_as_float(zz.z & 0xffff0000u), z6 = __uint_as_float(zz.w << 16), z7 = __uint_as_float(zz.w & 0xffff0000u);
                        v0 = (f32x4){z0 * sigmoidf_(v0[0]), z1 * sigmoidf_(v0[1]), z2 * sigmoidf_(v0[2]), z3 * sigmoidf_(v0[3])};
                        v1 = (f32x4){z4 * sigmoidf_(v1[0]), z5 * sigmoidf_(v1[1]), z6 * sigmoidf_(v1[2]), z7 * sigmoidf_(v1[3])};
                    }
                    acc[ai][bj][m][0] = v0; acc[ai][bj][m][1] = v1;
                    s += (v0[0] * v0[0] + v0[1] * v0[1]) + (v0[2] * v0[2] + v0[3] * v0[3]) + (v1[0] * v1[0] + v1[1] * v1[1]) + (v1[2] * v1[2] + v1[3] * v1[3]);
                }
                s += shx(s, 16, ln); s += shx(s, 32, ln);
                if (fq == 0) P[lrow * 4 + wc] = s;
                asm volatile("" ::: "memory");
            }
        asm volatile("s_waitcnt lgkmcnt(0)" ::: "memory"); __builtin_amdgcn_s_barrier(); asm volatile("" ::: "memory");
#pragma unroll
        for (int ai = 0; ai < 2; ++ai)
#pragma unroll
            for (int m = 0; m < 4; ++m) {
                const int lrow = ai * HALF + wr * 64 + m * 16 + fr, row = u.pm * BM + lrow;
                const f32x4 pp = *(const PG8_LAS f32x4*)(P + lrow * 4); const float rs = 1.0f / sqrtf(((pp[0] + pp[1]) + (pp[2] + pp[3])) * (1.0f / 256.0f) + mdl::RMS_EPS);
#pragma unroll
                for (int bj = 0; bj < 2; ++bj) { const f32x4 v0 = acc[ai][bj][m][0] * rs, v1 = acc[ai][bj][m][1] * rs;
                    u32x4 w; w.x = cvt_pk_bf16(v0[0], v0[1]); w.y = cvt_pk_bf16(v0[2], v0[3]); w.z = cvt_pk_bf16(v1[0], v1[1]); w.w = cvt_pk_bf16(v1[2], v1[3]);
                    *(u32x4*)(out + (size_t)row * mdl::DM + ocol + bj * HALF + lcol) = w; }
                asm volatile("" ::: "memory");
            }
        asm volatile("s_waitcnt lgkmcnt(0)" ::: "memory"); __builtin_amdgcn_s_barrier(); asm volatile("" ::: "memory");
    }
};
struct OneUnit {
    int pm; bool on;
    __device__ __forceinline__ bool next(int i, Unit& u) const { if (i > 0 || !on) return false; u.pm = pm; u.pn = 0; return true; }
    __device__ __forceinline__ void a_ready(const Unit&) const {}
    __device__ __forceinline__ void done(const Unit&) const {}
};
}
namespace pg8 {
template <class Epi, class Sched, bool ALIGN_EPI = false, bool SP2 = false>
__device__ __forceinline__ void gemm_phase(PG8_LAS unsigned char* lds, const Gemm g, const Sched& S, const Epi& E) {
    int tid_ = threadIdx.x; asm volatile("" : "+v"(tid_));
    const int tid = tid_, wid = __builtin_amdgcn_readfirstlane(tid >> 6), lane = tid & 63, wr = wid >> 2, wc = wid & 3, fr = lane & 15, fq = lane >> 4;
    const int K = g.K, nt = K / BK;
    unsigned voffA[2], voffB[2];
#pragma unroll
    for (int i = 0; i < 2; ++i) { int R, C; stage_rc(tid * 16 + i * 8192, R, C); const int Rb = Epi::PERM ? ((R & ~31) + perm32(R & 31)) : R;
        voffA[i] = (unsigned)(R * K + C) * 2u; voffB[i] = (unsigned)(Rb * K + C) * 2u; }
    const size_t kstep = (size_t)(BK * 2);
    const size_t hstep = (size_t)HALF * K * 2;
    const size_t tstep = 2 * hstep;
    const unsigned ldsw = (unsigned)wid * 1024u;
    const int aoff = lds_byte(wr * 64 + fr, fq * 8), boff = lds_byte(wc * 32 + fr, fq * 8);
#define PG8_SA(b, h) (((b) * 2 + (h)) * HTB)
#define PG8_SB(b, h) ((4 + (b) * 2 + (h)) * HTB)
#define PG8_STAGE(bufoff, gbase, voff) do { _Pragma("unroll") for (int _i = 0; _i < 2; ++_i) \
        __builtin_amdgcn_global_load_lds((const unsigned*)((const char*)(gbase) + (voff)[_i]), (PG8_LAS unsigned*)(lds + (bufoff) + ldsw + _i * 8192), 16, 0, 0); } while (0)
#define PG8_LDA(dst, b, h) do { _Pragma("unroll") for (int m = 0; m < 4; ++m) _Pragma("unroll") for (int k = 0; k < 2; ++k) dst[m][k] = *(const PG8_LAS bf16x8*)(lds + PG8_SA(b, h) + aoff + m * 2048 + k * 1024); } while (0)
#define PG8_LDB(dst, b, h) do { _Pragma("unroll") for (int n = 0; n < 2; ++n) _Pragma("unroll") for (int k = 0; k < 2; ++k) dst[n][k] = *(const PG8_LAS bf16x8*)(lds + PG8_SB(b, h) + boff + n * 2048 + k * 1024); } while (0)
#define PG8_MMA(ai, bj, At, Bt) do { __builtin_amdgcn_s_setprio(1); _Pragma("unroll") for (int m = 0; m < 4; ++m) _Pragma("unroll") for (int n = 0; n < 2; ++n) _Pragma("unroll") for (int k = 0; k < 2; ++k) \
        acc[ai][bj][m][n] = __builtin_amdgcn_mfma_f32_16x16x32_bf16(Bt[n][k], At[m][k], acc[ai][bj][m][n], 0, 0, 0); __builtin_amdgcn_s_setprio(0); } while (0)
#define PG8_WAIT_V(n) asm volatile("s_waitcnt vmcnt(" #n ")" ::: "memory")
#define PG8_WAIT_L(n) asm volatile("s_waitcnt lgkmcnt(" #n ")" ::: "memory")
#define PG8_BAR __builtin_amdgcn_s_barrier()
#define PG8_SCHED __builtin_amdgcn_sched_barrier(0)
    Unit cur, nxt; int ui = 0;
    if (!S.next(0, cur)) return;
    f32x4 acc[2][2][4][2];
#pragma unroll
    for (int a = 0; a < 2; ++a)
#pragma unroll
        for (int b = 0; b < 2; ++b)
#pragma unroll
            for (int m = 0; m < 4; ++m)
#pragma unroll
                for (int n = 0; n < 2; ++n) acc[a][b][m][n] = (f32x4){0.f, 0.f, 0.f, 0.f};
    bf16x8 At[4][2], B0[2][2], B1[2][2];
    const char* cA = (const char*)g.A + (size_t)cur.pm * tstep; const char* cB = (const char*)g.Bt + (size_t)cur.pn * tstep;
    S.a_ready(cur);
    if constexpr (SP2) {
        PG8_STAGE(PG8_SB(0, 0), cB, voffB); PG8_STAGE(PG8_SB(0, 1), cB + hstep, voffB); PG8_STAGE(PG8_SA(0, 0), cA, voffA); PG8_STAGE(PG8_SA(0, 1), cA + hstep, voffA);
        if (wr == 1) PG8_BAR;
        PG8_WAIT_V(2); PG8_BAR;
        PG8_STAGE(PG8_SB(1, 0), cB + kstep, voffB); PG8_STAGE(PG8_SA(1, 0), cA + kstep, voffA); PG8_STAGE(PG8_SB(1, 1), cB + hstep + kstep, voffB);
        PG8_WAIT_V(6); PG8_BAR;
    } else {
        PG8_STAGE(PG8_SB(0, 0), cB, voffB); PG8_STAGE(PG8_SA(0, 0), cA, voffA); PG8_STAGE(PG8_SB(0, 1), cB + hstep, voffB); PG8_STAGE(PG8_SA(0, 1), cA + hstep, voffA);
        if (wr == 1) PG8_BAR;
        PG8_WAIT_V(4); PG8_BAR;
        PG8_STAGE(PG8_SB(1, 0), cB + kstep, voffB); PG8_STAGE(PG8_SA(1, 0), cA + kstep, voffA); PG8_STAGE(PG8_SB(1, 1), cB + hstep + kstep, voffB);
        PG8_WAIT_V(6); PG8_BAR;
    }
    for (;;) {
        const bool has_next = S.next(ui + 1, nxt);
        const char* nA = has_next ? (const char*)g.A + (size_t)nxt.pm * tstep : cA; const char* nB = has_next ? (const char*)g.Bt + (size_t)nxt.pn * tstep : cB;
        for (int t = 0; t < nt; t += 2) {
            const bool last = (t == nt - 2);
            const char* a1 = cA + (size_t)(t + 1) * kstep;
            const char* a2 = last ? nA : cA + (size_t)(t + 2) * kstep; const char* b2 = last ? nB : cB + (size_t)(t + 2) * kstep;
            const char* a3 = a2 + kstep; const char* b3 = b2 + kstep;
            if (last && has_next) S.a_ready(nxt);
            if constexpr (SP2) {
            PG8_LDB(B0, 0, 0); PG8_LDB(B1, 0, 1); PG8_SCHED; PG8_LDA(At, 0, 0); PG8_STAGE(PG8_SA(1, 1), a1 + hstep, voffA);
            PG8_WAIT_V(8); PG8_WAIT_L(0); PG8_BAR; PG8_MMA(0, 0, At, B0); PG8_MMA(0, 1, At, B1); PG8_BAR; PG8_SCHED;
            PG8_LDA(At, 0, 1); PG8_STAGE(PG8_SB(0, 0), b2, voffB); PG8_STAGE(PG8_SB(0, 1), b2 + hstep, voffB); PG8_STAGE(PG8_SA(0, 0), a2, voffA);
            PG8_WAIT_V(8); PG8_WAIT_L(0); PG8_BAR; PG8_MMA(1, 0, At, B0); PG8_MMA(1, 1, At, B1); PG8_BAR; PG8_SCHED;
            PG8_LDB(B0, 1, 0); PG8_LDB(B1, 1, 1); PG8_SCHED; PG8_LDA(At, 1, 0); PG8_STAGE(PG8_SA(0, 1), a2 + hstep, voffA);
            PG8_WAIT_V(8); PG8_WAIT_L(0); PG8_BAR; PG8_MMA(0, 0, At, B0); PG8_MMA(0, 1, At, B1); PG8_BAR; PG8_SCHED;
            PG8_LDA(At, 1, 1); PG8_STAGE(PG8_SB(1, 0), b3, voffB); PG8_STAGE(PG8_SB(1, 1), b3 + hstep, voffB); PG8_STAGE(PG8_SA(1, 0), a3, voffA);
            PG8_WAIT_V(8); PG8_WAIT_L(0); PG8_BAR; PG8_MMA(1, 0, At, B0); PG8_MMA(1, 1, At, B1); PG8_BAR; PG8_SCHED;
            } else {
            PG8_LDB(B0, 0, 0); PG8_SCHED; PG8_LDA(At, 0, 0); PG8_STAGE(PG8_SA(1, 1), a1 + hstep, voffA);
            PG8_WAIT_L(8); PG8_BAR; PG8_WAIT_L(0); PG8_MMA(0, 0, At, B0); PG8_BAR; PG8_SCHED;
            PG8_LDB(B1, 0, 1); PG8_STAGE(PG8_SB(0, 0), b2, voffB);
            PG8_BAR; PG8_WAIT_L(0); PG8_MMA(0, 1, At, B1); PG8_BAR;
            PG8_LDA(At, 0, 1); PG8_STAGE(PG8_SA(0, 0), a2, voffA);
            PG8_BAR; PG8_WAIT_L(0); PG8_MMA(1, 0, At, B0); PG8_BAR; PG8_SCHED;
            PG8_STAGE(PG8_SB(0, 1), b2 + hstep, voffB);
            PG8_WAIT_V(6); PG8_BAR; PG8_MMA(1, 1, At, B1); PG8_BAR;
            PG8_LDB(B0, 1, 0); PG8_SCHED; PG8_LDA(At, 1, 0); PG8_STAGE(PG8_SA(0, 1), a2 + hstep, voffA);
            PG8_WAIT_L(8); PG8_BAR; PG8_WAIT_L(0); PG8_MMA(0, 0, At, B0); PG8_BAR; PG8_SCHED;
            PG8_LDB(B1, 1, 1); PG8_STAGE(PG8_SB(1, 0), b3, voffB);
            PG8_BAR; PG8_WAIT_L(0); PG8_MMA(0, 1, At, B1); PG8_BAR;
            PG8_LDA(At, 1, 1); PG8_STAGE(PG8_SA(1, 0), a3, voffA);
            PG8_BAR; PG8_WAIT_L(0); PG8_MMA(1, 0, At, B0); PG8_BAR; PG8_SCHED;
            PG8_STAGE(PG8_SB(1, 1), b3 + hstep, voffB);
            PG8_WAIT_V(6); PG8_BAR; PG8_MMA(1, 1, At, B1); PG8_BAR;
            }
        }
        if constexpr (ALIGN_EPI) { if (wr == 0) PG8_BAR; }
        if constexpr (!Epi::AFTER_DRAIN) { E(acc, cur, wr, wc, fr, fq); S.done(cur); }
        if (!has_next) break;
#pragma unroll
        for (int a = 0; a < 2; ++a)
#pragma unroll
            for (int b = 0; b < 2; ++b)
#pragma unroll
                for (int m = 0; m < 4; ++m)
#pragma unroll
                    for (int n = 0; n < 2; ++n) acc[a][b][m][n] = (f32x4){0.f, 0.f, 0.f, 0.f};
        cur = nxt; cA = nA; cB = nB; ++ui;
        if constexpr (ALIGN_EPI) { if (wr == 1) PG8_BAR; }
    }
    PG8_WAIT_V(0);
    if constexpr (!ALIGN_EPI) { if (wr == 0) PG8_BAR; }
    PG8_BAR;
    if constexpr (Epi::AFTER_DRAIN) { E.fused(acc, cur, wr, wc, fr, fq, lds, wid, lane); S.done(cur); }
#undef PG8_SA
#undef PG8_SB
#undef PG8_STAGE
#undef PG8_LDA
#undef PG8_LDB
#undef PG8_MMA
#undef PG8_WAIT_V
#undef PG8_WAIT_L
#undef PG8_BAR
#undef PG8_SCHED
}
}
#include <hip/hip_bf16.h>
#include <cmath>
namespace attn_body {
using bf16=__hip_bfloat16;
using bf16x8=__attribute__((ext_vector_type(8)))short;
using s16x4=__attribute__((ext_vector_type(4)))short;
using f32x16=__attribute__((ext_vector_type(16)))float;
using u32x4=__attribute__((ext_vector_type(4)))unsigned;
constexpr int BATCH=8,NHEAD=8,SEQ=4096,D=64,DM=NHEAD*D,OP=1024;
constexpr int NW=8,QBLK=32,QB=QBLK*NW,KVBLK=64,NQB=SEQ/QB;
constexpr int ATTN_PITCH=DM, ATTN_UNIT_ROWS=QB;
__device__ __forceinline__ int crow(int r,int hi){return (r&3)+8*(r>>2)+4*hi;}
#define SBAR() __builtin_amdgcn_sched_barrier(0)
__device__ __forceinline__ void cmask(f32x16&p0,f32x16&p1,int jb,int qrel,int hi){
  const float NEG=-INFINITY; int kb=64*jb+4*hi;
  #pragma unroll
  for(int r=0;r<16;++r){int kv=kb+(r&3)+8*(r>>2); if(kv>qrel)p0[r]=NEG; if(kv+32>qrel)p1[r]=NEG;}
}

constexpr int NSLOT=3, SLOTB=8192;
constexpr int LDS_K=0, LDS_V=NSLOT*SLOTB, LDS_WS=2*NSLOT*SLOTB, LDS_OST=LDS_WS+NW*64*4, LDS_BYTES=LDS_OST+NW*4096;
constexpr float C2=0.125f*1.4426950408889634f;
__device__ __forceinline__ void glds16(const void*gsrc,unsigned lds_dst){unsigned keep;
  asm volatile("s_mov_b32 %0, m0\n\ts_mov_b32 m0, %2\n\ts_nop 0\n\tglobal_load_lds_dwordx4 %1, off\n\ts_mov_b32 m0, %0":"=&s"(keep):"v"(gsrc),"s"(lds_dst):"memory");}
__device__ __forceinline__ float max3f(float a,float b,float c){float r;asm("v_max3_f32 %0, %1, %2, %3":"=v"(r):"v"(a),"v"(b),"v"(c));return r;}
__device__ __forceinline__ float max2f(float a,float b){float r;asm("v_max_f32_e32 %0, %1, %2":"=v"(r):"v"(a),"v"(b));return r;}
__device__ __forceinline__ float fadd_s(float a,float b){float r;asm("v_add_f32_e32 %0, %1, %2":"=v"(r):"v"(a),"v"(b));return r;}
__device__ __forceinline__ float fsub_s(float a,float b){float r;asm("v_sub_f32_e32 %0, %1, %2":"=v"(r):"v"(a),"v"(b));return r;}
typedef float f32x2_t __attribute__((ext_vector_type(2))); typedef __bf16 bf16x2_t __attribute__((ext_vector_type(2)));
__device__ __forceinline__ unsigned cvtpk_s(float lo,float hi){f32x2_t v={lo,hi};bf16x2_t b=__builtin_convertvector(v,bf16x2_t);return __builtin_bit_cast(unsigned,b);}
#define WAIT_BAR(N) asm volatile("s_waitcnt vmcnt(" #N ") lgkmcnt(0)\n\ts_barrier":::"memory")

__device__ __forceinline__ void qkt(f32x16&p0,f32x16&p1,const char*Kslot,const bf16x8*qr,const f32x16&negm,int r32,int hi){
  const char*kb=Kslot+hi*1024+r32*16;
  #pragma unroll
  for(int d0=0;d0<4;++d0){
    const bf16x8 b0=*reinterpret_cast<const bf16x8*>(kb+d0*2048);
    const bf16x8 b1=*reinterpret_cast<const bf16x8*>(kb+d0*2048+512);
    if(d0==0){p0=__builtin_amdgcn_mfma_f32_32x32x16_bf16(b0,qr[0],negm,0,0,0);p1=__builtin_amdgcn_mfma_f32_32x32x16_bf16(b1,qr[0],negm,0,0,0);}
    else{p0=__builtin_amdgcn_mfma_f32_32x32x16_bf16(b0,qr[d0],p0,0,0,0);p1=__builtin_amdgcn_mfma_f32_32x32x16_bf16(b1,qr[d0],p1,0,0,0);}}
}
typedef __attribute__((address_space(3))) const char* lds_cptr;
typedef short v4i16_t __attribute__((ext_vector_type(4)));
__device__ __forceinline__ void kload8(bf16x8*kf,lds_cptr kp){
  kf[0]=*(const __attribute__((address_space(3))) bf16x8*)(kp);      kf[1]=*(const __attribute__((address_space(3))) bf16x8*)(kp+512);
  kf[2]=*(const __attribute__((address_space(3))) bf16x8*)(kp+2048); kf[3]=*(const __attribute__((address_space(3))) bf16x8*)(kp+2560);
  kf[4]=*(const __attribute__((address_space(3))) bf16x8*)(kp+4096); kf[5]=*(const __attribute__((address_space(3))) bf16x8*)(kp+4608);
  kf[6]=*(const __attribute__((address_space(3))) bf16x8*)(kp+6144); kf[7]=*(const __attribute__((address_space(3))) bf16x8*)(kp+6656);
}
__device__ __forceinline__ void kload2(bf16x8*kf,lds_cptr kp,int j){ kf[2*j]=*(const __attribute__((address_space(3))) bf16x8*)(kp+j*2048); kf[2*j+1]=*(const __attribute__((address_space(3))) bf16x8*)(kp+j*2048+512); }
__device__ __forceinline__ s16x4 vtr(lds_cptr p){ return __builtin_bit_cast(s16x4,__builtin_amdgcn_ds_read_tr16_b64_v4i16((__attribute__((address_space(3))) v4i16_t*)p)); }
__device__ __forceinline__ float rowmax(const f32x16&p0,const f32x16&p1){
  float a=max3f(p0[0],p0[1],p1[0]),b=max3f(p0[2],p0[3],p1[1]);a=max3f(a,p1[2],p1[3]);
  #pragma unroll
  for(int r=4;r<16;r+=4){a=max3f(a,p0[r],p0[r+1]);b=max3f(b,p0[r+2],p0[r+3]);a=max3f(a,p1[r],p1[r+1]);b=max3f(b,p1[r+2],p1[r+3]);}
  const float m=max2f(a,b);
  auto rr=__builtin_amdgcn_permlane32_swap(__float_as_uint(m),__float_as_uint(m),false,false);
  return max2f(__uint_as_float(rr[0]),__uint_as_float(rr[1]));
}
__device__ __forceinline__ void pv(f32x16*o,int vb,bf16x8 pa0,bf16x8 pa1,bf16x8 pa2,bf16x8 pa3){
  #pragma unroll
  for(int d0=0;d0<2;++d0){s16x4 lo[4],hi[4];
    #pragma unroll
    for(int ks=0;ks<4;++ks){
      asm volatile("ds_read_b64_tr_b16 %0,%1 offset:%c2":"=&v"(lo[ks]):"v"(vb),"i"(d0*4096+ks*1024):"memory");
      asm volatile("ds_read_b64_tr_b16 %0,%1 offset:%c2":"=&v"(hi[ks]):"v"(vb),"i"(d0*4096+ks*1024+512):"memory");}
    asm volatile("s_waitcnt lgkmcnt(0)":::"memory");SBAR();
    #define PK(k) (bf16x8){lo[k][0],lo[k][1],lo[k][2],lo[k][3],hi[k][0],hi[k][1],hi[k][2],hi[k][3]}
    o[d0]=__builtin_amdgcn_mfma_f32_32x32x16_bf16(pa0,PK(0),o[d0],0,0,0);
    o[d0]=__builtin_amdgcn_mfma_f32_32x32x16_bf16(pa1,PK(1),o[d0],0,0,0);
    o[d0]=__builtin_amdgcn_mfma_f32_32x32x16_bf16(pa2,PK(2),o[d0],0,0,0);
    o[d0]=__builtin_amdgcn_mfma_f32_32x32x16_bf16(pa3,PK(3),o[d0],0,0,0);
    #undef PK
  }
}

#ifndef ATTN_STORE16
#define ATTN_STORE16(p,v) (*(u32x4*)(p)=(v))
#endif
#define KT(s) ((s)<4?4*qb+(s):(s)-4)
template<int THRL> __device__ __forceinline__ void attn_unit(int b,int h,int qb,unsigned selbits,const bf16*Q,const bf16*__restrict__ K,const bf16*__restrict__ V,bf16*O,char*shm){
  int tid_=threadIdx.x; asm volatile("":"+v"(tid_));
  const int tid=tid_,lane=tid&63,r32=lane&31,hi=lane>>5; const int wid=__builtin_amdgcn_readfirstlane(tid>>6);
  const long rowbase=(long)b*SEQ; const int q0=qb*QB;
  const bf16*Qw=Q+(rowbase+q0+wid*QBLK)*DM+h*D;
  const bf16*Kh=K+rowbase*DM+h*D,*Vh=V+rowbase*DM+h*D;
  const unsigned lds0=(unsigned)(uintptr_t)shm;
  float*wsf=(float*)(shm+LDS_WS)+wid*64;
  const bf16*ksrc=Kh+(long)lane*DM+wid*8;
  const bf16*vsrc=Vh+(long)(16*(wid&3)+(lane>>2))*DM+(wid>>2)*32+(lane&3)*8;
  const unsigned kdst=lds0+LDS_K+wid*1024, vdst=lds0+LDS_V+wid*1024;
  #define DMA_K(t,slot) glds16(ksrc+(long)KT(t)*KVBLK*DM,(unsigned)__builtin_amdgcn_readfirstlane(kdst+(slot)))
  #define DMA_V(t,slot) glds16(vsrc+(long)KT(t)*KVBLK*DM,(unsigned)__builtin_amdgcn_readfirstlane(vdst+(slot)))
  const int vb0=(int)(lds0+LDS_V)+((lane>>4)&1)*32+(lane&3)*8+(4*hi+((lane&15)>>2))*64;
  const char*Kbase=shm+LDS_K; bf16x8 kf[8];
  const lds_cptr shm3=(lds_cptr)shm; const lds_cptr kp0=shm3+LDS_K+hi*1024+r32*16; const lds_cptr vp0=shm3+LDS_V+((lane>>4)&1)*32+(lane&3)*8+(4*hi+((lane&15)>>2))*64;
  const int NT=(q0+QB)/KVBLK;
  DMA_K(0,0);DMA_V(0,0);DMA_K(1,SLOTB);
  bf16x8 qr[4];
  #pragma unroll
  for(int d0=0;d0<4;++d0)qr[d0]=*reinterpret_cast<const bf16x8*>(&Qw[(long)r32*DM+d0*16+hi*8]);
  float mhat=0.f,l_reg=0.f;f32x16 o[2];o[0]=f32x16{};o[1]=f32x16{};const f32x16 zero16=f32x16{};
  const int qrel=wid*QBLK+r32;
  #define CMASK(P0,P1,t) do{ if((t)<4){cmask(P0,P1,(t),qrel,hi);} }while(0)
  bool resc=false;
  #define START(P0,P1) do{ const float rm=rowmax(P0,P1); resc=false; \
    { const float dl=rm; mhat=fadd_s(mhat,dl); \
      _Pragma("unroll") for(int r=0;r<16;++r){P0[r]=fsub_s(P0[r],dl);P1[r]=fsub_s(P1[r],dl);} \
      } \
    _Pragma("unroll") for(int r=0;r<16;++r)P0[r]=__builtin_amdgcn_exp2f(P0[r]); }while(0)
  #define RESC() do{ if(resc){ asm volatile("s_waitcnt lgkmcnt(0)":::"memory"); \
      _Pragma("unroll") for(int d_=0;d_<2;++d_) _Pragma("unroll") for(int r=0;r<16;++r)o[d_][r]*=wsf[crow(r,hi)]; } }while(0)
  f32x16 pA0,pA1,pB0,pB1;
  int sl_prev=0,sl_cur=0,sl_next=SLOTB;
  #define ROT() do{sl_prev=sl_cur;sl_cur=sl_next;sl_next=(sl_next==(NSLOT-1)*SLOTB)?0:sl_next+SLOTB;}while(0)
  DMA_K(2,2*SLOTB);
  WAIT_BAR(3);
  qkt(pA0,pA1,Kbase,qr,zero16,r32,hi);asm volatile("s_nop 15\n\ts_nop 7":"+v"(pA0),"+v"(pA1));CMASK(pA0,pA1,0);
  START(pA0,pA1);
  _Pragma("unroll") for(int r=0;r<16;++r)pA1[r]=__builtin_amdgcn_exp2f(pA1[r]);
  WAIT_BAR(0);
  DMA_K(3,0);DMA_V(1,SLOTB);
  ROT();
  kload8(kf,kp0+sl_cur);
  WAIT_BAR(2);
  s16x4 vlo[8],vhi[8]; u32x4 pw0,pw1,pw2,pw3;
  #define PKW(P,B) cvtpk_s(P[B],P[B+1])
  #define PAF(k) __builtin_bit_cast(bf16x8,pw##k)
  #define VFR(i) (bf16x8){vlo[i][0],vlo[i][1],vlo[i][2],vlo[i][3],vhi[i][0],vhi[i][1],vhi[i][2],vhi[i][3]}
  #define PIN(x) asm volatile("":"+v"(x))
  #define MX3(a,b,c) __builtin_fmaxf(__builtin_fmaxf((a),(b)),(c))
  #define GAPA(MF,A0,A1,A2,A3,W0,W1,PW) do{ MF; sacc+=A0; sacc+=A1; sacc+=A2; sacc+=A3; PIN(sacc); W0; W1; PIN(PW); SBAR(); }while(0)
  #define EX(v) __builtin_amdgcn_exp2f(v)
  #define GAPB(MF,X,B) do{ MF; X[B]=EX(X[B]); X[B+1]=EX(X[B+1]); X[B+2]=EX(X[B+2]); X[B+3]=EX(X[B+3]); PIN(X); SBAR(); }while(0)
  #define VRD(i) do{ vlo[i]=vtr(vp_+(((i)>>2)*4096+((i)&3)*1024)); vhi[i]=vtr(vp_+(((i)>>2)*4096+((i)&3)*1024+512)); }while(0)
  #define KRD(G,j) do{ if(G){ kload2(kf,kp0+sl_next,j); SBAR(); } }while(0)
    \
  #define STEP(C0,C1,P0,P1,t,GK,GV,GL) do{ SBAR(); \
    { const float nm_=(((t)<4)||((selbits>>(((t)-4)>>2))&1u))?-mhat:-INFINITY; _Pragma("unroll") for(int r_=0;r_<16;++r_){C0[r_]=nm_;C1[r_]=nm_;} PIN(C0); PIN(C1); SBAR(); } \
    const lds_cptr vp_=vp0+sl_prev; \
    VRD(0); SBAR(); float sacc=(P0[0]+P0[1]); \
    GAPA(C0=__builtin_amdgcn_mfma_f32_32x32x16_bf16(kf[0],qr[0],C0,0,0,0), P0[2],P0[3],P0[4],P0[5],     pw0[0]=PKW(P0,0), pw0[1]=PKW(P0,2), pw0); \
    VRD(4); SBAR(); GAPA(C1=__builtin_amdgcn_mfma_f32_32x32x16_bf16(kf[1],qr[0],C1,0,0,0), P0[6],P0[7],P0[8],P0[9],     pw0[2]=PKW(P0,4), pw0[3]=PKW(P0,6), pw0); \
    VRD(1); SBAR(); GAPA(C0=__builtin_amdgcn_mfma_f32_32x32x16_bf16(kf[2],qr[1],C0,0,0,0),   P0[10],P0[11],P0[12],P0[13], pw1[0]=PKW(P0,8), pw1[1]=PKW(P0,10), pw1); \
    VRD(5); SBAR(); GAPA(C1=__builtin_amdgcn_mfma_f32_32x32x16_bf16(kf[3],qr[1],C1,0,0,0),   P0[14],P0[15],P1[0],P1[1],   pw1[2]=PKW(P0,12),pw1[3]=PKW(P0,14), pw1); \
    VRD(2); SBAR(); GAPA(C0=__builtin_amdgcn_mfma_f32_32x32x16_bf16(kf[4],qr[2],C0,0,0,0),   P1[2],P1[3],P1[4],P1[5],     pw2[0]=PKW(P1,0), pw2[1]=PKW(P1,2), pw2); \
    VRD(6); SBAR(); GAPA(C1=__builtin_amdgcn_mfma_f32_32x32x16_bf16(kf[5],qr[2],C1,0,0,0),   P1[6],P1[7],P1[8],P1[9],     pw2[2]=PKW(P1,4), pw2[3]=PKW(P1,6), pw2); \
    VRD(3); SBAR(); GAPA(C0=__builtin_amdgcn_mfma_f32_32x32x16_bf16(kf[6],qr[3],C0,0,0,0),   P1[10],P1[11],P1[12],P1[13], pw3[0]=PKW(P1,8), pw3[1]=PKW(P1,10), pw3); \
    VRD(7); SBAR(); GAPA(C1=__builtin_amdgcn_mfma_f32_32x32x16_bf16(kf[7],qr[3],C1,0,0,0),   P1[14],P1[15],0.f,0.f,       pw3[2]=PKW(P1,12),pw3[3]=PKW(P1,14), pw3); \
    l_reg+=sacc; \
    if(GK){DMA_K((t)+3,sl_cur);} if(GV){DMA_V((t)+1,sl_next);} \
    CMASK(C0,C1,t); \
    { float a=MX3(C0[0],C0[1],C1[0]),b=MX3(C0[2],C0[3],C1[1]); a=MX3(a,C1[2],C1[3]); \
      _Pragma("unroll") for(int r=4;r<16;r+=4){a=MX3(a,C0[r],C0[r+1]);b=MX3(b,C0[r+2],C0[r+3]);a=MX3(a,C1[r],C1[r+1]);b=MX3(b,C1[r+2],C1[r+3]);} \
      float rm=__builtin_fmaxf(a,b); { auto rr=__builtin_amdgcn_permlane32_swap(__float_as_uint(rm),__float_as_uint(rm),false,false); rm=__builtin_fmaxf(__uint_as_float(rr[0]),__uint_as_float(rr[1])); } \
      resc=false; \
      if(__builtin_expect(__any(rm>(float)THRL),0)){ const float dl=__builtin_fmaxf(rm,0.f); mhat+=dl; \
        _Pragma("unroll") for(int r=0;r<16;++r){C0[r]-=dl;C1[r]-=dl;} \
        const float f=__builtin_amdgcn_exp2f(-dl); l_reg*=f; if(hi==0)wsf[r32]=f; resc=true; } } \
    SBAR(); \
    GAPB(o[0]=__builtin_amdgcn_mfma_f32_32x32x16_bf16(PAF(0),VFR(0),o[0],0,0,0), C0,0); \
    GAPB(o[1]=__builtin_amdgcn_mfma_f32_32x32x16_bf16(PAF(0),VFR(4),o[1],0,0,0), C0,4); \
    KRD(GL,0); GAPB(o[0]=__builtin_amdgcn_mfma_f32_32x32x16_bf16(PAF(1),VFR(1),o[0],0,0,0), C0,8); \
    KRD(GL,1); GAPB(o[1]=__builtin_amdgcn_mfma_f32_32x32x16_bf16(PAF(1),VFR(5),o[1],0,0,0), C0,12); \
    KRD(GL,2); GAPB(o[0]=__builtin_amdgcn_mfma_f32_32x32x16_bf16(PAF(2),VFR(2),o[0],0,0,0), C1,0); \
    KRD(GL,3); GAPB(o[1]=__builtin_amdgcn_mfma_f32_32x32x16_bf16(PAF(2),VFR(6),o[1],0,0,0), C1,4); \
    GAPB(o[0]=__builtin_amdgcn_mfma_f32_32x32x16_bf16(PAF(3),VFR(3),o[0],0,0,0), C1,8); \
    GAPB(o[1]=__builtin_amdgcn_mfma_f32_32x32x16_bf16(PAF(3),VFR(7),o[1],0,0,0), C1,12); \
    }while(0)
  int t=1;
  for(;t+5<NT;t+=2){
    STEP(pB0,pB1,pA0,pA1,t,true,true,true);     WAIT_BAR(2); RESC(); ROT();
    STEP(pA0,pA1,pB0,pB1,t+1,true,true,true);   WAIT_BAR(2); RESC(); ROT();
  }
  #define ENDW(tt) do{ if((tt)+3<NT){WAIT_BAR(2);} else if((tt)+2<NT){WAIT_BAR(1);} else {WAIT_BAR(0);} }while(0)
  for(;t+1<NT;t+=2){
    STEP(pB0,pB1,pA0,pA1,t,(t+3<NT),(t+1<NT),(t+1<NT));       ENDW(t);   RESC(); ROT();
    STEP(pA0,pA1,pB0,pB1,t+1,(t+4<NT),(t+2<NT),(t+2<NT));     ENDW(t+1); RESC(); ROT();
  }
  STEP(pB0,pB1,pA0,pA1,NT-1,false,false,false); RESC();
  { float sacc=pB0[0]+pB0[1]; _Pragma("unroll") for(int r=2;r<16;++r)sacc+=pB0[r]; _Pragma("unroll") for(int r=0;r<16;++r)sacc+=pB1[r]; l_reg+=sacc;
    pw0=(u32x4){PKW(pB0,0),PKW(pB0,2),PKW(pB0,4),PKW(pB0,6)};pw1=(u32x4){PKW(pB0,8),PKW(pB0,10),PKW(pB0,12),PKW(pB0,14)};pw2=(u32x4){PKW(pB1,0),PKW(pB1,2),PKW(pB1,4),PKW(pB1,6)};pw3=(u32x4){PKW(pB1,8),PKW(pB1,10),PKW(pB1,12),PKW(pB1,14)};
    SBAR(); pv(o,vb0+sl_cur,PAF(0),PAF(1),PAF(2),PAF(3)); }
  #undef PKW
  #undef PAF
  #undef VFR
  #undef PIN
  #undef MX3
  #undef GAPA
  #undef GAPB
  #undef EX
  #undef VRD
  #undef KRD
  #undef STEP
  #undef ENDW
  {auto rr=__builtin_amdgcn_permlane32_swap(__float_as_uint(l_reg),__float_as_uint(l_reg),false,false);l_reg=__uint_as_float(rr[0])+__uint_as_float(rr[1]);}
  if(hi==0)wsf[32+r32]=l_reg;asm volatile("s_waitcnt lgkmcnt(0)":::"memory");
  float rli[16];
  #pragma unroll
  for(int r=0;r<16;++r)rli[r]=__builtin_amdgcn_rcpf(wsf[32+crow(r,hi)]);
  bf16*Ow=O+(rowbase+q0+wid*QBLK)*OP+h*D;
  { bf16*stg=(bf16*)(shm+LDS_OST)+wid*2048;
    #pragma unroll
    for(int r=0;r<16;++r){const int orow=crow(r,hi);
      #pragma unroll
      for(int d0=0;d0<2;++d0)stg[orow*64+d0*32+r32]=__float2bfloat16(o[d0][r]*rli[r]);}
    asm volatile("s_waitcnt lgkmcnt(0)":::"memory");
    #pragma unroll
    for(int i=0;i<4;++i){const int row=i*8+(lane>>3),ch=lane&7; const u32x4 v=*(const u32x4*)(stg+row*64+ch*8); ATTN_STORE16(Ow+(long)row*OP+ch*8,v);} }
  asm volatile("s_waitcnt lgkmcnt(0)\n\ts_barrier":::"memory");
  #undef DMA_K
  #undef DMA_V
  #undef CMASK
  #undef START
  #undef RESC
  #undef ROT
}
constexpr int ATTN_LDS_BYTES=LDS_BYTES;
#undef KT
#undef SBAR
#undef WAIT_BAR
}
#define GAS __attribute__((address_space(1)))
#define LAS __attribute__((address_space(3)))
typedef unsigned short bf16;
typedef unsigned v4u __attribute__((ext_vector_type(4)));
typedef float f32x4 __attribute__((ext_vector_type(4)));
typedef short bf16x8 __attribute__((ext_vector_type(8)));
typedef GAS unsigned gu32;
typedef GAS unsigned long long gu64;
#define RLX_AGENT __ATOMIC_RELAXED, __HIP_MEMORY_SCOPE_AGENT
#define LDS_WAIT() asm volatile("s_waitcnt lgkmcnt(0)" ::: "memory")
#define VM_WAIT() asm volatile("s_waitcnt vmcnt(0)" ::: "memory")
__device__ __forceinline__ unsigned long long rt() { return __builtin_amdgcn_s_memrealtime(); }
__device__ __forceinline__ unsigned f2bf(float f) { unsigned u = __builtin_bit_cast(unsigned, f); return (u + 0x7fffu + ((u >> 16) & 1u)) >> 16; }
__device__ __forceinline__ unsigned pk2(float lo, float hi) { return f2bf(lo) | (f2bf(hi) << 16); }

#define XB_TMO      128
#define XB_XCNT(j)  (256  + 64 * (j))
#define XB_XSUB(j)  (1280 + 64 * (j))
#define XB_XGEN(j)  (2304 + 64 * (j))
#define XB_TOP      3328
#define XB_TOPGEN   3392
#define XCD_BAR_WORDS 3456
#define XB_SPIN_CAP (1u << 18)

__device__ __forceinline__ unsigned xb_ld(unsigned* p)              { return __hip_atomic_load(p, __ATOMIC_RELAXED, __HIP_MEMORY_SCOPE_AGENT); }
__device__ __forceinline__ unsigned xb_add(unsigned* p, unsigned v) { return __hip_atomic_fetch_add(p, v, __ATOMIC_RELAXED, __HIP_MEMORY_SCOPE_AGENT); }
__device__ __forceinline__ unsigned xb_xcc_id() { return (unsigned)__builtin_amdgcn_s_getreg((3 << 11) | 20) & 0xFu; }
#define XB_SPIN(cond, bar) do { unsigned _sp = 0; while (cond) { __builtin_amdgcn_s_sleep(1); \
    if ((++_sp & 255u) == 0u) { if (xb_ld(&(bar)[XB_TMO])) break; if (_sp > XB_SPIN_CAP) { atomicAdd(&(bar)[XB_TMO], 1u); break; } } } } while (0)

struct XcdBarrier {
    unsigned* bar; unsigned x;
    volatile LAS unsigned* st;
};

__device__ __forceinline__ XcdBarrier xcd_barrier_post(unsigned* bar, volatile LAS unsigned* st) {
    XcdBarrier b; b.bar = bar; b.x = xb_xcc_id(); b.st = st;
    if (threadIdx.x == 0) (void)xb_add(&bar[XB_XCNT(b.x)], 1u);
    return b;
}
__device__ __forceinline__ void xcd_barrier_complete(unsigned* bar, unsigned x, unsigned& nloc, unsigned& nx) {
    const unsigned G = gridDim.x * gridDim.y * gridDim.z;
    unsigned sum, cnt, mine, sp = 0u;
    for (;;) {
        sum = 0u; cnt = 0u; mine = 0u;
#pragma unroll
        for (unsigned j = 0; j < 16; ++j) { const unsigned c = xb_ld(&bar[XB_XCNT(j)]); sum += c; cnt += (c > 0u) ? 1u : 0u; mine = (j == x) ? c : mine; }
        if (sum == G) break;
        __builtin_amdgcn_s_sleep(1);
        if ((++sp & 255u) == 0u) { if (xb_ld(&bar[XB_TMO])) break; if (sp > XB_SPIN_CAP) { atomicAdd(&bar[XB_TMO], 1u); break; } }
    }
    nloc = mine > 0u ? mine : 1u; nx = cnt > 0u ? cnt : 1u;
}

__device__ __forceinline__ void xcd_barrier(const XcdBarrier& b) {
    asm volatile("s_waitcnt vmcnt(0)" ::: "memory");
    __syncthreads();
    if (threadIdx.x == 0) {
        unsigned* bar = b.bar;
        __builtin_amdgcn_s_waitcnt(0);
        unsigned nloc = b.st[0], nx = b.st[1];
        if (nloc == 0u) { xcd_barrier_complete(bar, b.x, nloc, nx); b.st[0] = nloc; b.st[1] = nx; }
        const unsigned old = xb_add(&bar[XB_XSUB(b.x)], 1u);
        const unsigned gen = old / nloc;
        if (old + 1u == (gen + 1u) * nloc) {
            __builtin_amdgcn_fence(__ATOMIC_RELEASE, "agent");
            asm volatile("s_waitcnt vmcnt(0)" ::: "memory");
            const unsigned og = xb_add(&bar[XB_TOP], 1u);
            const unsigned tg = og / nx;
            if (og + 1u == (tg + 1u) * nx) xb_add(&bar[XB_TOPGEN], 1u);
            else XB_SPIN(xb_ld(&bar[XB_TOPGEN]) == tg, bar);
            __builtin_amdgcn_fence(__ATOMIC_ACQUIRE, "agent");
            xb_add(&bar[XB_XGEN(b.x)], 1u);
            asm volatile("s_waitcnt vmcnt(0)" ::: "memory");
        } else {
            XB_SPIN(xb_ld(&bar[XB_XGEN(b.x)]) == gen, bar);
            __builtin_amdgcn_fence(__ATOMIC_ACQUIRE, "agent");
            asm volatile("s_waitcnt vmcnt(0)" ::: "memory");
        }
    }
    __syncthreads();
}

using namespace mdl;
constexpr int NWAVES = 8;
#ifndef SSM_NAIVE
#define SSM_NAIVE 0
#endif
#ifndef ATTN_NAIVE
#define ATTN_NAIVE 0
#endif
#ifndef DUPM
#define DUPM 0
#endif
#define NREP(t) ((((DUPM) >> (t)) & 1) ? 2 : 1)
#ifndef MK_ONE_LAUNCH
#define MK_ONE_LAUNCH 1
#endif
constexpr int N_PHASES = 14;
constexpr size_t MiB = 1u << 20;
constexpr size_t WS_CTL = 0, CTL_ZERO_BYTES = 1 * MiB;
constexpr size_t WS_ROPE = 1 * MiB;
constexpr size_t WS_KMP = 1 * MiB + 512 * 1024;
constexpr size_t WS_SSQ = 2 * MiB;
constexpr size_t WS_W = 8 * MiB, W_LAYER = 24 * MiB;
constexpr size_t WO_IN = 0, WO_OUT = 5 * MiB, WO_GU = 7 * MiB, WO_DN = 18 * MiB, WO_GLU = 23 * MiB + 512 * 1024, WO_PW2 = 23 * MiB + 768 * 1024;
constexpr size_t WS_HB = 64 * MiB;
constexpr size_t WS_QB = 128 * MiB, WS_KB = 160 * MiB, WS_VB = 192 * MiB, WS_QF = 224 * MiB, WS_US = 288 * MiB, WS_UC = 304 * MiB, WS_Z = 320 * MiB, WS_YC = 336 * MiB, WS_MIX = 352 * MiB;
constexpr size_t WS_ACT = 128 * MiB;
constexpr size_t WS_END = 432 * MiB;
static_assert(WS_ACT + (size_t)M * D_FF * 2 <= WS_UC + 16 * MiB && WS_MIX + (size_t)M * DM * 2 <= WS_END, "d_ws map");
constexpr int CW_TMO = 0, CW_CODE = 1, CW_BAR = 4096;
constexpr int RING_OFF = 0, RING_BYTES = 131072;
constexpr int LDSCTL_OFF = RING_BYTES, MISC_OFF = LDSCTL_OFF + 320;
constexpr int LDS_BYTES = 147456;

struct Frame {
    LAS unsigned char* lds;
    volatile LAS unsigned* MISC;
    gu32* ctl;
    int tid, lane, wave;
    int vcu, G;
    unsigned char* ws;
};
using pg8::shx;
__device__ __forceinline__ float wave_sum(float v, int ln) {
#pragma unroll
    for (int o = 1; o < 64; o <<= 1) v += shx(v, o, ln);
    return v;
}
__device__ __forceinline__ float wave_max(float v, int ln) {
#pragma unroll
    for (int o = 1; o < 64; o <<= 1) v = fmaxf(v, shx(v, o, ln));
    return v;
}
__device__ __forceinline__ float bf2f(bf16 v) { return __uint_as_float((unsigned)v << 16); }

__device__ __forceinline__ void p0_transpose_item(const float* W, int K, int Nsrc, bf16* WT, int k0, int nsrc0, int nout0, const float* ks, LAS float* scr, int lane) {
#pragma unroll 8
    for (int i = 0; i < 32; ++i) { const int kk = 2 * i + (lane >> 5); float v = W[(size_t)(k0 + kk) * Nsrc + nsrc0 + (lane & 31)]; if (ks) v *= ks[k0 + kk]; scr[kk * 33 + (lane & 31)] = v; }
    LDS_WAIT(); asm volatile("" ::: "memory");
    const int c = lane & 7;
#pragma unroll
    for (int j = 0; j < 4; ++j) { const int n = (lane >> 3) + 8 * j; const LAS float* s = scr + (8 * c) * 33 + n;
        v4u o; o.x = pk2(s[0 * 33], s[1 * 33]); o.y = pk2(s[2 * 33], s[3 * 33]); o.z = pk2(s[4 * 33], s[5 * 33]); o.w = pk2(s[6 * 33], s[7 * 33]);
        *(GAS v4u*)(WT + (size_t)(nout0 + n) * K + k0 + 8 * c) = o; }
    LDS_WAIT(); asm volatile("" ::: "memory");
}
struct Inputs { const float* p[27]; };
__device__ __forceinline__ void ssm_build_item(Frame& F, const Inputs& I, int lg);
__device__ __forceinline__ void p0_prologue(Frame& F, const Inputs& I) {
    LAS float* scr = (LAS float*)(F.lds + RING_OFF + F.wave * 16384);
    const int gw = F.vcu * NWAVES + F.wave, NGW = F.G * NWAVES;
    constexpr int I_IN = 16 * 72, I_OUT = 16 * 32, I_GU = 16 * 176, I_DN = 44 * 32, I_SM = 4 * 8;
    constexpr int I_LAYER = I_IN + I_OUT + I_GU + I_DN + 2 * I_SM;
    for (int it = gw; it < DEPTH * I_LAYER; it += NGW) {
        const int l = it / I_LAYER; int r = it % I_LAYER;
        unsigned char* wl = F.ws + WS_W + (size_t)l * W_LAYER;
        if (r < I_IN) { const int kb = r / 72, nb = r % 72, n0 = nb * 32; int src = n0;
            if (n0 >= 1792) { const int q = n0 - 1792, j = q >> 8, rr = q & 255; src = ((rr >> 7) ? 2048 : 1792) + 128 * j + (rr & 127); }
            p0_transpose_item(I.p[2] + (size_t)l * DM * D_IN, DM, D_IN, (bf16*)(wl + WO_IN), kb * 64, src, n0, I.p[1] + l * DM, scr, F.lane); continue; }
        r -= I_IN;
        if (r < I_OUT) { const int kb = r / 32, nb = r % 32, k0 = kb * 64;
            const float* ks = k0 < 512 ? I.p[19] + l * 512 - 0 : (k0 < 768 ? I.p[20] + l * 256 - 512 : I.p[21] + l * 256 - 768);
            p0_transpose_item(I.p[22] + (size_t)l * DM * DM, DM, DM, (bf16*)(wl + WO_OUT), k0, nb * 32, nb * 32, ks, scr, F.lane); continue; }
        r -= I_OUT;
        if (r < I_GU) { const int kb = r / 176, nb = r % 176, n0 = nb * 32; const int j = n0 >> 8, rr = n0 & 255; const int src = ((rr >> 7) ? D_FF : 0) + 128 * j + (rr & 127);
            p0_transpose_item(I.p[24] + (size_t)l * DM * D_GU, DM, D_GU, (bf16*)(wl + WO_GU), kb * 64, src, n0, I.p[23] + l * DM, scr, F.lane); continue; }
        r -= I_GU;
        if (r < I_DN) { const int kb = r / 32, nb = r % 32;
            p0_transpose_item(I.p[25] + (size_t)l * D_FF * DM, D_FF, DM, (bf16*)(wl + WO_DN), kb * 64, nb * 32, nb * 32, nullptr, scr, F.lane); continue; }
        r -= I_DN;
        if (r < I_SM) { const int kb = r / 8, nb = r % 8;
            p0_transpose_item(I.p[11] + (size_t)l * 65536, 256, 256, (bf16*)(wl + WO_GLU), kb * 64, nb * 32, nb * 32, nullptr, scr, F.lane); continue; }
        r -= I_SM;
        { const int kb = r / 8, nb = r % 8;
            p0_transpose_item(I.p[17] + (size_t)l * 65536, 256, 256, (bf16*)(wl + WO_PW2), kb * 64, nb * 32, nb * 32, nullptr, scr, F.lane); }
    }
    for (int it = F.vcu; it < DEPTH * NGRP; it += F.G) ssm_build_item(F, I, it);
    const float* x = I.p[0]; bf16* hb = (bf16*)(F.ws + WS_HB); float* ssq = (float*)(F.ws + WS_SSQ);
    for (int m = gw; m < M; m += NGW) {
        const GAS f32x4* xr = (const GAS f32x4*)(x + (size_t)m * DM) + F.lane; f32x4 v[4]; float s = 0.f;
#pragma unroll
        for (int j = 0; j < 4; ++j) { v[j] = xr[64 * j]; s += (v[j].x * v[j].x + v[j].y * v[j].y) + (v[j].z * v[j].z + v[j].w * v[j].w); }
        s = wave_sum(s, F.lane);
        GAS unsigned long long* o8 = (GAS unsigned long long*)(hb + (size_t)m * DM) + F.lane;
#pragma unroll
        for (int j = 0; j < 4; ++j) o8[64 * j] = (unsigned long long)pk2(v[j].x, v[j].y) | ((unsigned long long)pk2(v[j].z, v[j].w) << 32);
        if (F.lane < 16) ssq[(size_t)m * 16 + F.lane] = F.lane == 0 ? s : 0.f;
    }
    float* rope = (float*)(F.ws + WS_ROPE);
    for (int i = gw * 64 + F.lane; i < SEQ * 8; i += NGW * 64) { const int pos = i >> 3, f = i & 7;
        const float inv = powf(500000.0f, -(float)(2 * f) / 16.0f); const float ang = (float)pos * inv;
        rope[2 * i] = cosf(ang); rope[2 * i + 1] = sinf(ang); }
}

__device__ __forceinline__ void attn_naive_unit(Frame& F, int b, int h, int qb) {
    LAS float* km = (LAS float*)(F.lds);
    LAS unsigned* selm = (LAS unsigned*)(F.lds + 4096);
    LAS float* sc = (LAS float*)(F.lds + 8192) + F.wave * 1024;
    LAS float* qs = (LAS float*)(F.lds + 8192 + 8 * 4096) + F.wave * 64;
    const float* kmp = (const float*)(F.ws + WS_KMP); const float* Qf = (const float*)(F.ws + WS_QF);
    const bf16* Qb = (const bf16*)(F.ws + WS_QB); const bf16* Kb = (const bf16*)(F.ws + WS_KB); const bf16* Vb = (const bf16*)(F.ws + WS_VB); bf16* mix = (bf16*)(F.ws + WS_MIX);
    __syncthreads();
    for (int i = F.tid; i < 16 * 64; i += 512) { const int n = i >> 6, d = i & 63; float v = 0.f;
        if (n < qb) { const size_t idx = ((size_t)(b * NBLK + n) * 512) + h * 64 + d; v = (kmp[idx] + kmp[(size_t)BATCH * NBLK * 512 + idx]) * (1.0f / 256.0f); }
        km[i] = v; }
    __syncthreads();
    if (F.tid < 256) {
        const float* q = Qf + ((size_t)(b * SEQ + qb * 256 + F.tid)) * 512 + h * 64;
        float g[15];
#pragma unroll
        for (int n = 0; n < 15; ++n) g[n] = 0.f;
        for (int d4 = 0; d4 < 16; ++d4) { const f32x4 qv = *(const f32x4*)(q + 4 * d4);
#pragma unroll
            for (int n = 0; n < 15; ++n) { const LAS float* kk = km + n * 64 + 4 * d4; g[n] += (qv.x * kk[0] + qv.y * kk[1]) + (qv.z * kk[2] + qv.w * kk[3]); } }
        unsigned mask = 0u; const int topk = qb < 3 ? qb : 3;
        for (int k = 0; k < topk; ++k) { float best = -INFINITY; int bi = 0;
#pragma unroll
            for (int n = 0; n < 15; ++n) { const bool ok = n < qb && !((mask >> n) & 1u) && g[n] > best; best = ok ? g[n] : best; bi = ok ? n : bi; }
            mask |= 1u << bi; }
        selm[F.tid] = mask;
    }
    __syncthreads();
    for (int i = 0; i < 32; ++i) {
        const int t = F.wave * 32 + i, qpos = qb * 256 + t; const size_t row = (size_t)b * SEQ + qpos;
        const unsigned mask = selm[t] | (1u << qb);
        qs[F.lane] = bf2f(Qb[row * 512 + h * 64 + F.lane]);
        LDS_WAIT();
        int cnt = 0; float mx = -INFINITY;
        for (int n = 0; n <= qb; ++n) { if (!((mask >> n) & 1u)) continue;
            for (int kk = 0; kk < 4; ++kk) { const int key0 = n * 256 + kk * 64; if (key0 > qpos) break; const int key = key0 + F.lane;
                const v4u* kr = (const v4u*)(Kb + ((size_t)b * SEQ + key) * 512 + h * 64); float s = 0.f;
#pragma unroll
                for (int c = 0; c < 8; ++c) { const v4u w = kr[c]; const LAS float* qq = qs + 8 * c;
                    s += qq[0] * __uint_as_float(w.x << 16) + qq[1] * __uint_as_float(w.x & 0xffff0000u) + qq[2] * __uint_as_float(w.y << 16) + qq[3] * __uint_as_float(w.y & 0xffff0000u)
                       + qq[4] * __uint_as_float(w.z << 16) + qq[5] * __uint_as_float(w.z & 0xffff0000u) + qq[6] * __uint_as_float(w.w << 16) + qq[7] * __uint_as_float(w.w & 0xffff0000u); }
                if (key > qpos) s = -INFINITY;
                sc[cnt * 64 + F.lane] = s; mx = fmaxf(mx, s); ++cnt; } }
        mx = wave_max(mx, F.lane); float l = 0.f;
        for (int c = 0; c < cnt; ++c) { const float p = exp2f(sc[c * 64 + F.lane] - mx); sc[c * 64 + F.lane] = p; l += p; }
        l = wave_sum(l, F.lane); LDS_WAIT();
        float o = 0.f; int c = 0;
        for (int n = 0; n <= qb; ++n) { if (!((mask >> n) & 1u)) continue;
            for (int kk = 0; kk < 4; ++kk) { const int key0 = n * 256 + kk * 64; if (key0 > qpos) break;
                const bf16* vr = Vb + ((size_t)b * SEQ + key0) * 512 + h * 64 + F.lane;
#pragma unroll 8
                for (int j = 0; j < 64; ++j) o += sc[c * 64 + j] * bf2f(vr[(size_t)j * 512]);
                ++c; } }
        mix[row * DM + h * 64 + F.lane] = (bf16)f2bf(o / l);
        LDS_WAIT();
    }
}

__device__ __forceinline__ float gelu_tanh(float x) { const float u = 0.7978845608028654f * (x + 0.044715f * x * x * x); return 0.5f * x * (1.0f + tanhf(u)); }
__device__ __forceinline__ void ssm_naive_unit(Frame& F, const Inputs& I, int l, int b, int g) {
    const int p = F.lane, w = F.wave;
    LAS float* S = (LAS float*)(F.lds + LDSCTL_OFF + 1024);
    LAS unsigned char* ubuf = F.lds + w * 16384;
    const size_t gp = ((size_t)l * NGRP + g) * NST + p;
    const float dt = expf(I.p[5][l * NGRP + g]); const float lr = I.p[3][gp], li = I.p[4][gp];
    const float mag = expf(lr * dt); const float ar = mag * cosf(li * dt), ai = mag * sinf(li * dt);
    const float nr = ar - 1.0f, den = lr * lr + li * li; const float fr = (nr * lr + ai * li) / den, fi = (ai * lr - nr * li) / den;
    float bbr[16], bbi[16], cr[16], ci[16], dsk[16];
#pragma unroll
    for (int c = 0; c < 16; ++c) { const float br = I.p[6][gp * 16 + c], bi = I.p[7][gp * 16 + c]; bbr[c] = fr * br - fi * bi; bbi[c] = fr * bi + fi * br;
        const size_t ci_ = (((size_t)l * NGRP + g) * GCH + c) * NST + p; cr[c] = I.p[8][ci_]; ci[c] = I.p[9][ci_]; dsk[c] = I.p[10][(l * NGRP + g) * GCH + c]; }
    const bf16* Us = (const bf16*)(F.ws + WS_US); bf16* Z = (bf16*)(F.ws + WS_Z);
    const size_t row0 = (size_t)b * SEQ + w * 512;
    __syncthreads();
#pragma unroll 4
    for (int k = 0; k < 16; ++k) { const int j = p + 64 * k; *(LAS v4u*)(ubuf + j * 16) = *(const v4u*)(Us + (row0 + (j >> 1)) * 256 + g * 16 + (j & 1) * 8); }
    LDS_WAIT();
    float hr = 0.f, hi = 0.f;
    for (int t = 0; t < 512; ++t) {
        const LAS v4u* ur = (const LAS v4u*)(ubuf + t * 32); const v4u u0 = ur[0], u1 = ur[1];
        const float uu[16] = {__uint_as_float(u0.x << 16), __uint_as_float(u0.x & 0xffff0000u), __uint_as_float(u0.y << 16), __uint_as_float(u0.y & 0xffff0000u), __uint_as_float(u0.z << 16), __uint_as_float(u0.z & 0xffff0000u), __uint_as_float(u0.w << 16), __uint_as_float(u0.w & 0xffff0000u),
                              __uint_as_float(u1.x << 16), __uint_as_float(u1.x & 0xffff0000u), __uint_as_float(u1.y << 16), __uint_as_float(u1.y & 0xffff0000u), __uint_as_float(u1.z << 16), __uint_as_float(u1.z & 0xffff0000u), __uint_as_float(u1.w << 16), __uint_as_float(u1.w & 0xffff0000u)};
        float xr = 0.f, xi = 0.f;
#pragma unroll
        for (int c = 0; c < 16; ++c) { xr += bbr[c] * uu[c]; xi += bbi[c] * uu[c]; }
        const float nr2 = ar * hr - ai * hi + xr, ni2 = ar * hi + ai * hr + xi; hr = nr2; hi = ni2;
    }
    __syncthreads();
    S[(w * 64 + p) * 2] = hr; S[(w * 64 + p) * 2 + 1] = hi;
    __syncthreads();
    float pr = ar, pi = ai;
#pragma unroll
    for (int k = 0; k < 9; ++k) { const float t0 = pr * pr - pi * pi, t1 = 2.0f * pr * pi; pr = t0; pi = t1; }
    hr = 0.f; hi = 0.f;
    for (int j = 0; j < w; ++j) { const float sr = S[(j * 64 + p) * 2], si = S[(j * 64 + p) * 2 + 1]; const float t0 = pr * hr - pi * hi + sr, t1 = pr * hi + pi * hr + si; hr = t0; hi = t1; }
    for (int t = 0; t < 512; ++t) {
        const LAS v4u* ur = (const LAS v4u*)(ubuf + t * 32); const v4u u0 = ur[0], u1 = ur[1];
        const float uu[16] = {__uint_as_float(u0.x << 16), __uint_as_float(u0.x & 0xffff0000u), __uint_as_float(u0.y << 16), __uint_as_float(u0.y & 0xffff0000u), __uint_as_float(u0.z << 16), __uint_as_float(u0.z & 0xffff0000u), __uint_as_float(u0.w << 16), __uint_as_float(u0.w & 0xffff0000u),
                              __uint_as_float(u1.x << 16), __uint_as_float(u1.x & 0xffff0000u), __uint_as_float(u1.y << 16), __uint_as_float(u1.y & 0xffff0000u), __uint_as_float(u1.z << 16), __uint_as_float(u1.z & 0xffff0000u), __uint_as_float(u1.w << 16), __uint_as_float(u1.w & 0xffff0000u)};
        float xr = 0.f, xi = 0.f;
#pragma unroll
        for (int c = 0; c < 16; ++c) { xr += bbr[c] * uu[c]; xi += bbi[c] * uu[c]; }
        const float nr2 = ar * hr - ai * hi + xr, ni2 = ar * hi + ai * hr + xi; hr = nr2; hi = ni2;
        float v[16];
#pragma unroll
        for (int c = 0; c < 16; ++c) v[c] = cr[c] * hr - ci[c] * hi;
        float v8[8], v4[4], v2[2], v1;
        { const bool up = (p & 32) != 0;
#pragma unroll
          for (int c = 0; c < 8; ++c) { const float keep = up ? v[c + 8] : v[c], send = up ? v[c] : v[c + 8]; v8[c] = keep + shx(send, 32, p); } }
        { const bool up = (p & 16) != 0;
#pragma unroll
          for (int c = 0; c < 4; ++c) { const float keep = up ? v8[c + 4] : v8[c], send = up ? v8[c] : v8[c + 4]; v4[c] = keep + shx(send, 16, p); } }
        { const bool up = (p & 8) != 0;
#pragma unroll
          for (int c = 0; c < 2; ++c) { const float keep = up ? v4[c + 2] : v4[c], send = up ? v4[c] : v4[c + 2]; v2[c] = keep + shx(send, 8, p); } }
        { const bool up = (p & 4) != 0; const float keep = up ? v2[1] : v2[0], send = up ? v2[0] : v2[1]; v1 = keep + shx(send, 4, p); }
        v1 += shx(v1, 2, p); v1 += shx(v1, 1, p);
        const int c = ((p >> 5) & 1) * 8 + ((p >> 4) & 1) * 4 + ((p >> 3) & 1) * 2 + ((p >> 2) & 1);
        float uc = uu[0], dc = dsk[0];
#pragma unroll
        for (int k = 1; k < 16; ++k) { uc = (c == k) ? uu[k] : uc; dc = (c == k) ? dsk[k] : dc; }
        const float y = v1 + dc * uc;
        if ((p & 3) == 0) Z[(row0 + t) * 256 + g * 16 + c] = (bf16)f2bf(gelu_tanh(y));
    }
}


constexpr size_t WS_SSMF = 424 * MiB;
constexpr int SSM_NFR = 200, SSM_TOFF = 0, SSM_POFF = 72, SSM_QOFF = 136;
__host__ __device__ constexpr int ssm_toff(int mt) { return (mt & 1) ? ((mt >> 1) + 1) * ((mt >> 1) + 1) : (mt >> 1) * ((mt >> 1) + 1); }
__device__ __forceinline__ void cmul(float ar, float ai, float br, float bi, float& cr, float& ci) { cr = ar * br - ai * bi; ci = ar * bi + ai * br; }

__device__ __forceinline__ void ssm_build_item(Frame& F, const Inputs& I, int lg) {
    LAS float* apow = (LAS float*)(F.lds);
    LAS float* bbar = apow + 64 * 17 * 2;
    LAS float* cc = bbar + 64 * 16 * 2;
    LAS float* Kt = cc + 16 * 64 * 2;
    const int tid = F.tid;
    __syncthreads();
    if (tid < 64) {
        const int p = tid; const size_t gp = (size_t)lg * NST + p;
        const float dt = expf(I.p[5][lg]); const float lr = I.p[3][gp], li = I.p[4][gp];
        const float mag = expf(lr * dt); const float ar = mag * cosf(li * dt), ai = mag * sinf(li * dt);
        const float nr = ar - 1.0f, den = lr * lr + li * li; const float fr = (nr * lr + ai * li) / den, fi = (ai * lr - nr * li) / den;
        float pr = 1.f, pi = 0.f;
        for (int t = 0; t <= 16; ++t) { apow[(p * 17 + t) * 2] = pr; apow[(p * 17 + t) * 2 + 1] = pi; float nr2, ni2; cmul(pr, pi, ar, ai, nr2, ni2); pr = nr2; pi = ni2; }
        for (int c = 0; c < 16; ++c) { const float br = I.p[6][gp * 16 + c], bi = I.p[7][gp * 16 + c]; bbar[(p * 16 + c) * 2] = fr * br - fi * bi; bbar[(p * 16 + c) * 2 + 1] = fr * bi + fi * br; }
    }
    for (int i = tid; i < 1024; i += 512) { cc[2 * i] = I.p[8][(size_t)lg * 1024 + i]; cc[2 * i + 1] = I.p[9][(size_t)lg * 1024 + i]; }
    __syncthreads();
    for (int e = tid; e < 4096; e += 512) { const int tau = e >> 8, c = (e >> 4) & 15, c2 = e & 15; float s = 0.f;
        for (int p = 0; p < 64; ++p) { float tr, ti; cmul(apow[(p * 17 + tau) * 2], apow[(p * 17 + tau) * 2 + 1], bbar[(p * 16 + c2) * 2], bbar[(p * 16 + c2) * 2 + 1], tr, ti);
            s += cc[(c * 64 + p) * 2] * tr - cc[(c * 64 + p) * 2 + 1] * ti; }
        if (tau == 0 && c == c2) s += I.p[10][lg * 16 + c];
        Kt[e] = s; }
    __syncthreads();
    bf16* fb = (bf16*)(F.ws + WS_SSMF) + (size_t)lg * SSM_NFR * 512;
    for (int it = tid; it < SSM_NFR * 64; it += 512) {
        const int fi_ = it >> 6, l = it & 63, q4 = l >> 4, i16 = l & 15; float v[8];
        if (fi_ < SSM_POFF) {
            int mt = 0;
#pragma unroll
            for (int m = 1; m < 16; ++m) if (fi_ >= ssm_toff(m)) mt = m;
            const int kt = fi_ - ssm_toff(mt), s2 = 2 * kt + (q4 >> 1), c2b = 8 * (q4 & 1);
#pragma unroll
            for (int j = 0; j < 8; ++j) v[j] = (s2 <= mt) ? Kt[((mt - s2) * 16 + i16) * 16 + c2b + j] : 0.f;
        } else if (fi_ < SSM_QOFF) {
            const int f2 = fi_ - SSM_POFF, mp = f2 >> 3, kt = f2 & 7, p = 8 * mp + (i16 >> 1), ri = i16 & 1, s2 = 2 * kt + (q4 >> 1), c2b = 8 * (q4 & 1);
            const float pr = apow[(p * 17 + 15 - s2) * 2], pi = apow[(p * 17 + 15 - s2) * 2 + 1];
#pragma unroll
            for (int j = 0; j < 8; ++j) { float wr_, wi_; cmul(pr, pi, bbar[(p * 16 + c2b + j) * 2], bbar[(p * 16 + c2b + j) * 2 + 1], wr_, wi_); v[j] = ri ? wi_ : wr_; }
        } else {
            const int f2 = fi_ - SSM_QOFF, mt = f2 >> 2, kq = f2 & 3;
#pragma unroll
            for (int j = 0; j < 8; ++j) { const int kk = 32 * kq + 8 * q4 + j, p = kk >> 1, ri = kk & 1; float wr_, wi_;
                cmul(cc[(i16 * 64 + p) * 2], cc[(i16 * 64 + p) * 2 + 1], apow[(p * 17 + mt + 1) * 2], apow[(p * 17 + mt + 1) * 2 + 1], wr_, wi_); v[j] = ri ? -wi_ : wr_; }
        }
        v4u o; o.x = pk2(v[0], v[1]); o.y = pk2(v[2], v[3]); o.z = pk2(v[4], v[5]); o.w = pk2(v[6], v[7]);
        *(GAS v4u*)(fb + (size_t)it * 8) = o;
    }
    __syncthreads();
}

template <int CTRL> __device__ __forceinline__ float dpp_shr0(float v) {
    return __builtin_bit_cast(float, __builtin_amdgcn_update_dpp(0, __builtin_bit_cast(int, v), CTRL, 0xf, 0xf, true)); }
__device__ __forceinline__ float row_last(float v) {
    return __builtin_bit_cast(float, __builtin_amdgcn_ds_swizzle(__builtin_bit_cast(int, v), 0x1F0)); }
__device__ __forceinline__ float gelu_fast(float x) { const float u = 0.7978845608028654f * (x + 0.044715f * x * x * x); const float e = __expf(2.0f * u); return x * (1.0f - 1.0f / (1.0f + e)); }

constexpr int SSM_UB = 8704, SSM_HB = 4352;
__device__ __forceinline__ void ssm_mfma_unit(Frame& F, const Inputs& I, unsigned char* wsu, int l, int b, int g) {
    typedef short bf16x8 __attribute__((ext_vector_type(8)));
    int tid = threadIdx.x; asm volatile("" : "+v"(tid));
    const int lane = tid & 63, w = __builtin_amdgcn_readfirstlane(tid >> 6), q4 = lane >> 4, n = lane & 15;
    const int lg = l * NGRP + g;
    LAS unsigned char* ubuf = F.lds; LAS unsigned char* hbuf = F.lds + 2 * SSM_UB;
    const bf16x8* fb = (const bf16x8*)(wsu + WS_SSMF) + (size_t)lg * SSM_NFR * 64 + lane;
    const int mtA = w, mtB = 15 - w, nA = (mtA >> 1) + 1, nB = (mtB >> 1) + 1;
    bf16x8 Pf[8], TA[4], TB[8], QA[4], QB[4];
#pragma unroll
    for (int k = 0; k < 8; ++k) Pf[k] = fb[(SSM_POFF + w * 8 + k) * 64];
#pragma unroll
    for (int k = 0; k < 4; ++k) TA[k] = fb[(ssm_toff(mtA) + (k < nA ? k : 0)) * 64];
#pragma unroll
    for (int k = 0; k < 8; ++k) TB[k] = fb[(ssm_toff(mtB) + (k < nB ? k : 0)) * 64];
#pragma unroll
    for (int k = 0; k < 4; ++k) { QA[k] = fb[(SSM_QOFF + mtA * 4 + k) * 64]; QB[k] = fb[(SSM_QOFF + mtB * 4 + k) * 64]; }
    float l1r[2], l1i[2], l2r[2], l2i[2], l4r[2], l4i[2], l8r[2], l8i[2], lnr[2], lni[2], l16r[2], l16i[2];
    { const float dt = expf(I.p[5][lg]);
#pragma unroll
      for (int s = 0; s < 2; ++s) { const size_t gp = (size_t)lg * NST + 8 * w + 2 * q4 + s; const float lr = I.p[3][gp], li = I.p[4][gp];
        const float mag = expf(lr * dt); float ar = mag * cosf(li * dt), ai = mag * sinf(li * dt), tr, ti;
#pragma unroll
        for (int k = 0; k < 4; ++k) { cmul(ar, ai, ar, ai, tr, ti); ar = tr; ai = ti; }
        l1r[s] = ar; l1i[s] = ai; cmul(ar, ai, ar, ai, l2r[s], l2i[s]); cmul(l2r[s], l2i[s], l2r[s], l2i[s], l4r[s], l4i[s]); cmul(l4r[s], l4i[s], l4r[s], l4i[s], l8r[s], l8i[s]);
        cmul(l8r[s], l8i[s], l8r[s], l8i[s], l16r[s], l16i[s]);
        float pr = 1.f, pi = 0.f;
        if (n & 1) { cmul(pr, pi, l1r[s], l1i[s], tr, ti); pr = tr; pi = ti; }
        if (n & 2) { cmul(pr, pi, l2r[s], l2i[s], tr, ti); pr = tr; pi = ti; }
        if (n & 4) { cmul(pr, pi, l4r[s], l4i[s], tr, ti); pr = tr; pi = ti; }
        if (n & 8) { cmul(pr, pi, l8r[s], l8i[s], tr, ti); pr = tr; pi = ti; }
        lnr[s] = pr; lni[s] = pi; } }
    float h0r[2] = {0.f, 0.f}, h0i[2] = {0.f, 0.f};
    const bf16* Us = (const bf16*)(wsu + WS_US); bf16* Z = (bf16*)(wsu + WS_Z);
    const size_t rowb = (size_t)b * SEQ;
    const int ctok = tid >> 1, chalf = tid & 1; const int cdst = (ctok >> 4) * 544 + (ctok & 15) * 32 + chalf * 16;
    const bf16* csrc = Us + (rowb + ctok) * 256 + g * 16 + chalf * 8;
    __syncthreads();
    { const v4u c0 = *(const v4u*)csrc; *(LAS v4u*)(ubuf + cdst) = c0; }
    v4u cnext = *(const v4u*)(csrc + (size_t)256 * 256);
    __syncthreads();
    const int urd = n * 544 + (q4 >> 1) * 32 + (q4 & 1) * 16;
    const int hwr = n * 272 + (16 * w + 4 * q4) * 2, hrd = n * 272 + q4 * 16;
    for (int k = 0; k < 16; ++k) {
        LAS unsigned char* ub = ubuf + (k & 1) * SSM_UB; LAS unsigned char* hb = hbuf + (k & 1) * SSM_HB;
        bf16x8 Uf[8];
#pragma unroll
        for (int kt = 0; kt < 8; ++kt) Uf[kt] = *(const LAS bf16x8*)(ub + urd + kt * 64);
        f32x4 S = (f32x4){0.f, 0.f, 0.f, 0.f};
#pragma unroll
        for (int kt = 0; kt < 8; ++kt) S = __builtin_amdgcn_mfma_f32_16x16x32_bf16(Pf[kt], Uf[kt], S, 0, 0, 0);
        float vr[2] = {S[0], S[2]}, vi[2] = {S[1], S[3]};
#pragma unroll
        for (int s = 0; s < 2; ++s) {
            float sr, si, tr, ti;
            sr = dpp_shr0<0x111>(vr[s]); si = dpp_shr0<0x111>(vi[s]); cmul(l1r[s], l1i[s], sr, si, tr, ti); vr[s] += tr; vi[s] += ti;
            sr = dpp_shr0<0x112>(vr[s]); si = dpp_shr0<0x112>(vi[s]); cmul(l2r[s], l2i[s], sr, si, tr, ti); vr[s] += tr; vi[s] += ti;
            sr = dpp_shr0<0x114>(vr[s]); si = dpp_shr0<0x114>(vi[s]); cmul(l4r[s], l4i[s], sr, si, tr, ti); vr[s] += tr; vi[s] += ti;
            sr = dpp_shr0<0x118>(vr[s]); si = dpp_shr0<0x118>(vi[s]); cmul(l8r[s], l8i[s], sr, si, tr, ti); vr[s] += tr; vi[s] += ti;
        }
        float hin[4];
#pragma unroll
        for (int s = 0; s < 2; ++s) {
            float tr, ti; cmul(lnr[s], lni[s], h0r[s], h0i[s], tr, ti);
            hin[2 * s] = dpp_shr0<0x111>(vr[s]) + tr; hin[2 * s + 1] = dpp_shr0<0x111>(vi[s]) + ti;
            float cr_, ci_; cmul(l16r[s], l16i[s], h0r[s], h0i[s], cr_, ci_);
            h0r[s] = row_last(vr[s]) + cr_; h0i[s] = row_last(vi[s]) + ci_;
        }
        *(LAS unsigned long long*)(hb + hwr) = (unsigned long long)pk2(hin[0], hin[1]) | ((unsigned long long)pk2(hin[2], hin[3]) << 32);
        if (k < 15) *(LAS v4u*)(ubuf + ((k + 1) & 1) * SSM_UB + cdst) = cnext;
        __syncthreads();
        if (k < 14) cnext = *(const v4u*)(csrc + (size_t)(k + 2) * 256 * 256);
        bf16x8 Hf[4];
#pragma unroll
        for (int kq = 0; kq < 4; ++kq) Hf[kq] = *(const LAS bf16x8*)(hb + hrd + kq * 64);
        f32x4 yA = (f32x4){0.f, 0.f, 0.f, 0.f}, yB = (f32x4){0.f, 0.f, 0.f, 0.f};
#pragma unroll
        for (int kt = 0; kt < 4; ++kt) if (kt < nA) yA = __builtin_amdgcn_mfma_f32_16x16x32_bf16(TA[kt], Uf[kt], yA, 0, 0, 0);
#pragma unroll
        for (int kt = 0; kt < 8; ++kt) if (kt < nB) yB = __builtin_amdgcn_mfma_f32_16x16x32_bf16(TB[kt], Uf[kt], yB, 0, 0, 0);
#pragma unroll
        for (int kq = 0; kq < 4; ++kq) { yA = __builtin_amdgcn_mfma_f32_16x16x32_bf16(QA[kq], Hf[kq], yA, 0, 0, 0); yB = __builtin_amdgcn_mfma_f32_16x16x32_bf16(QB[kq], Hf[kq], yB, 0, 0, 0); }
        bf16* zr = Z + (rowb + k * 256 + n * 16) * 256 + g * 16 + 4 * q4;
        *(unsigned long long*)(zr + (size_t)mtA * 256) = (unsigned long long)pk2(gelu_fast(yA[0]), gelu_fast(yA[1])) | ((unsigned long long)pk2(gelu_fast(yA[2]), gelu_fast(yA[3])) << 32);
        *(unsigned long long*)(zr + (size_t)mtB * 256) = (unsigned long long)pk2(gelu_fast(yB[0]), gelu_fast(yB[1])) | ((unsigned long long)pk2(gelu_fast(yB[2]), gelu_fast(yB[3])) << 32);
    }
    __syncthreads();
}

constexpr int CONVW_OFF = 0;
__device__ __forceinline__ void conv_pre_stage(Frame& F, const Inputs& I, int l) {
    __syncthreads();
    const float* cw = I.p[13] + (size_t)l * CWID * 256;
    for (int i = F.tid; i < CWID * 64; i += 512) *(LAS f32x4*)(F.lds + CONVW_OFF + i * 16) = *(const f32x4*)(cw + 4 * i);
    __syncthreads();
}
__device__ __forceinline__ void conv_pre_run(Frame& F, const Inputs& I, int l, int row0) {
    const bf16* Uc = (const bf16*)(F.ws + WS_UC); bf16* Yc = (bf16*)(F.ws + WS_YC);
    const int c0 = 4 * F.lane;
    const f32x4 bias = *(const f32x4*)(I.p[14] + l * 256 + c0), g = *(const f32x4*)(I.p[15] + l * 256 + c0), bb = *(const f32x4*)(I.p[16] + l * 256 + c0);
    for (int blk = 0; blk < 4; ++blk) {
        const int r0 = row0 + 8 * blk, t0 = r0 & (SEQ - 1);
        unsigned long long uw[CWID + 7];
#pragma unroll
        for (int i = 0; i < CWID + 7; ++i) { const int tt = t0 - (CWID - 1) + i; const unsigned long long v = *(const unsigned long long*)(Uc + (size_t)(tt >= 0 ? r0 - (CWID - 1) + i : r0) * 256 + c0); uw[i] = tt >= 0 ? v : 0ull; }
        f32x4 a[8];
#pragma unroll
        for (int o = 0; o < 8; ++o) a[o] = bias;
#pragma unroll
        for (int j = 0; j < CWID; ++j) { const f32x4 w = *(const LAS f32x4*)(F.lds + CONVW_OFF + (j * 64 + F.lane) * 16);
#pragma unroll
            for (int o = 0; o < 8; ++o) { const unsigned long long u = uw[o + j];
                a[o].x += w.x * __uint_as_float((unsigned)u << 16); a[o].y += w.y * __uint_as_float((unsigned)u & 0xffff0000u);
                a[o].z += w.z * __uint_as_float((unsigned)(u >> 32) << 16); a[o].w += w.w * __uint_as_float((unsigned)(u >> 32) & 0xffff0000u); } }
#pragma unroll
        for (int o = 0; o < 8; ++o) {
            f32x4 av = a[o];
            const float mu = wave_sum((av.x + av.y) + (av.z + av.w), F.lane) * (1.0f / 256.0f);
            av = av - mu;
            const float var = wave_sum((av.x * av.x + av.y * av.y) + (av.z * av.z + av.w * av.w), F.lane) * (1.0f / 256.0f);
            const float rs = 1.0f / sqrtf(var + LN_EPS);
            f32x4 y = av * rs * g + bb;
            y.x = y.x / (1.0f + __expf(-y.x)); y.y = y.y / (1.0f + __expf(-y.y)); y.z = y.z / (1.0f + __expf(-y.z)); y.w = y.w / (1.0f + __expf(-y.w));
            *(unsigned long long*)(Yc + (size_t)(r0 + o) * 256 + c0) = (unsigned long long)pk2(y.x, y.y) | ((unsigned long long)pk2(y.z, y.w) << 32);
        }
    }
}
__device__ __forceinline__ void attn_norm_row(Frame& F, int row) {
    bf16* mix = (bf16*)(F.ws + WS_MIX) + (size_t)row * DM + 8 * F.lane;
    const v4u w = *(const v4u*)mix;
    float v[8] = {__uint_as_float(w.x << 16), __uint_as_float(w.x & 0xffff0000u), __uint_as_float(w.y << 16), __uint_as_float(w.y & 0xffff0000u), __uint_as_float(w.z << 16), __uint_as_float(w.z & 0xffff0000u), __uint_as_float(w.w << 16), __uint_as_float(w.w & 0xffff0000u)};
    float s = 0.f;
#pragma unroll
    for (int k = 0; k < 8; ++k) s += v[k] * v[k];
    const float rs = 1.0f / sqrtf(wave_sum(s, F.lane) * (1.0f / 512.0f) + RMS_EPS);
    v4u o; o.x = pk2(v[0] * rs, v[1] * rs); o.y = pk2(v[2] * rs, v[3] * rs); o.z = pk2(v[4] * rs, v[5] * rs); o.w = pk2(v[6] * rs, v[7] * rs);
    *(v4u*)mix = o;
}
__device__ __forceinline__ void final_norm_row(Frame& F, float* out, const float* gain, int row) {
    const bf16* hp = (const bf16*)(F.ws + WS_HB) + (size_t)row * DM + 8 * F.lane;
    float v[16]; float s = 0.f;
#pragma unroll
    for (int j = 0; j < 2; ++j) { const v4u w = *(const v4u*)(hp + 512 * j);
        v[8 * j + 0] = __uint_as_float(w.x << 16); v[8 * j + 1] = __uint_as_float(w.x & 0xffff0000u); v[8 * j + 2] = __uint_as_float(w.y << 16); v[8 * j + 3] = __uint_as_float(w.y & 0xffff0000u);
        v[8 * j + 4] = __uint_as_float(w.z << 16); v[8 * j + 5] = __uint_as_float(w.z & 0xffff0000u); v[8 * j + 6] = __uint_as_float(w.w << 16); v[8 * j + 7] = __uint_as_float(w.w & 0xffff0000u); }
#pragma unroll
    for (int k = 0; k < 16; ++k) s += v[k] * v[k];
    const float rs = 1.0f / sqrtf(wave_sum(s, F.lane) * (1.0f / DM) + RMS_EPS);
#pragma unroll
    for (int j = 0; j < 2; ++j) { const f32x4 g0 = *(const f32x4*)(gain + 512 * j + 8 * F.lane), g1 = *(const f32x4*)(gain + 512 * j + 8 * F.lane + 4);
        GAS f32x4* o = (GAS f32x4*)(out + (size_t)row * DM + 512 * j + 8 * F.lane);
        o[0] = (f32x4){v[8 * j] * rs * g0.x, v[8 * j + 1] * rs * g0.y, v[8 * j + 2] * rs * g0.z, v[8 * j + 3] * rs * g0.w};
        o[1] = (f32x4){v[8 * j + 4] * rs * g1.x, v[8 * j + 5] * rs * g1.y, v[8 * j + 6] * rs * g1.z, v[8 * j + 7] * rs * g1.w}; }
}

constexpr int KM_OFF = 86016;
static_assert(attn_body::ATTN_LDS_BYTES <= KM_OFF && KM_OFF + 4096 <= RING_BYTES, "attention LDS map");
__device__ __forceinline__ unsigned moba_gate(Frame& F, unsigned char* wsu, int b, int h, int qb) {
    LAS float* km = (LAS float*)(F.lds + KM_OFF);
    int tid = threadIdx.x; asm volatile("" : "+v"(tid)); const int lane = tid & 63;
    const float* kmp = (const float*)(wsu + WS_KMP); const float* Qf = (const float*)(wsu + WS_QF);
    for (int i = tid; i < 16 * 64; i += 512) { const int n = i >> 6, d = i & 63; float v = 0.f;
        if (n < qb) { const size_t idx = ((size_t)(b * NBLK + n) * 512) + h * 64 + d; v = (kmp[idx] + kmp[(size_t)BATCH * NBLK * 512 + idx]) * (1.0f / 256.0f); }
        km[i] = v; }
    __syncthreads();
    const int r32 = lane & 31, hi = lane >> 5;
    const float* q = Qf + ((size_t)b * SEQ + qb * 256 + F.wave * 32 + r32) * 512 + h * 64 + hi * 32;
    float g[15];
#pragma unroll
    for (int n = 0; n < 15; ++n) g[n] = 0.f;
#pragma unroll 2
    for (int d4 = 0; d4 < 8; ++d4) { const f32x4 qv = *(const f32x4*)(q + 4 * d4);
#pragma unroll
        for (int n = 0; n < 15; ++n) { const LAS float* kk = km + n * 64 + hi * 32 + 4 * d4; g[n] += (qv.x * kk[0] + qv.y * kk[1]) + (qv.z * kk[2] + qv.w * kk[3]); } }
#pragma unroll
    for (int n = 0; n < 15; ++n) g[n] += shx(g[n], 32, lane);
    unsigned mask = 0u; const int topk = qb < 3 ? qb : 3;
    for (int k = 0; k < topk; ++k) { float best = -INFINITY; int bi = 0;
#pragma unroll
        for (int n = 0; n < 15; ++n) { const bool ok = n < qb && !((mask >> n) & 1u) && g[n] > best; best = ok ? g[n] : best; bi = ok ? n : bi; }
        mask |= 1u << bi; }
    return mask;
}

struct Args { Inputs in; float* out; unsigned char* ws; int ph_lo, ph_hi, li, pad; };
template <int PHM> __global__ void __launch_bounds__(NWAVES * 64, 2) skel_fwd(Args args) {
    extern __shared__ __attribute__((aligned(16))) unsigned char lds[];
#define FRAME() Frame F; { unsigned char* ws_ = args.ws; int t_ = threadIdx.x; asm volatile("" : "+s"(ws_), "+v"(t_)); F.lds = (LAS unsigned char*)lds; F.MISC = (volatile LAS unsigned*)(F.lds + MISC_OFF); \
        F.tid = t_; F.lane = t_ & 63; F.wave = __builtin_amdgcn_readfirstlane(t_ >> 6); F.G = gridDim.x; { const int bx = blockIdx.x; F.vcu = (F.G % 8 == 0) ? (bx % 8) * (F.G / 8) + bx / 8 : bx; } \
        F.ws = ws_; F.ctl = (gu32*)(ws_ + WS_CTL); } \
        bf16* const HB = (bf16*)(F.ws + WS_HB); float* const SSQ = (float*)(F.ws + WS_SSQ); bf16* const MIX = (bf16*)(F.ws + WS_MIX); const int gw = F.vcu * NWAVES + F.wave, NGW = F.G * NWAVES; (void)HB; (void)SSQ; (void)MIX; (void)gw; (void)NGW;
    LAS unsigned char* const lds0 = (LAS unsigned char*)lds;
    gu32* const ctl0 = (gu32*)(args.ws + WS_CTL);
    const Inputs& I = args.in;
    for (int u = threadIdx.x; u < (LDS_BYTES - LDSCTL_OFF) / 4; u += NWAVES * 64) ((LAS unsigned*)(lds0 + LDSCTL_OFF))[u] = 0u;
    __syncthreads();
    XcdBarrier bar; bar.bar = (unsigned*)(ctl0 + CW_BAR); bar.x = 0; bar.st = nullptr;
    if (MK_ONE_LAUNCH) bar = xcd_barrier_post((unsigned*)(ctl0 + CW_BAR), (volatile LAS unsigned*)(lds0 + MISC_OFF) + 8);
#define GRID_BAR() do { if (MK_ONE_LAUNCH) xcd_barrier(bar); } while (0)
    const int lo = args.ph_lo, hi = args.ph_hi;
#define PHON(t) (((PHM) >> (t)) & 1)
#define IN(k) (lo <= (k) && (k) < hi)
#define BOTH(k) (IN(k) && IN((k) + 1))

    if (PHON(0) && IN(0)) { FRAME(); p0_prologue(F, I); if (BOTH(0)) GRID_BAR(); }

    for (int l = 0; l < DEPTH; ++l) {
        const int pb = 1 + 6 * l;
#define WL() unsigned char* wl = F.ws + WS_W + (size_t)l * W_LAYER;
        if (PHON(1) && IN(pb)) { FRAME(); WL(); (void)wl;
            pg8::Gemm g{HB, (const bf16*)(wl + WO_IN), M, D_IN, DM}; pg8::StaticOrder S; S.init(M, D_IN, F.G, (int)blockIdx.x);
            pg8::EpiInProj E{SSQ, (const float*)(F.ws + WS_ROPE), (bf16*)(F.ws + WS_QB), (bf16*)(F.ws + WS_KB), (bf16*)(F.ws + WS_VB), (bf16*)(F.ws + WS_US), (bf16*)(F.ws + WS_UC), (float*)(F.ws + WS_QF), (float*)(F.ws + WS_KMP)};
            for (int rep = 0; rep < NREP(1); ++rep) { pg8::gemm_phase<pg8::EpiInProj, pg8::StaticOrder, true, true>(F.lds + RING_OFF, g, S, E); if (rep + 1 < NREP(1)) GRID_BAR(); }
            if (BOTH(pb)) GRID_BAR();
        }
        if (PHON(2) && IN(pb + 1)) { FRAME(); WL(); (void)wl;
            for (int rep = 0; rep < NREP(8); ++rep) if (F.vcu < BATCH * NGRP) {
#if SSM_NAIVE
                ssm_naive_unit(F, I, l, F.vcu / NGRP, F.vcu % NGRP);
#else
                { unsigned char* wsu = args.ws; asm volatile("" : "+s"(wsu)); ssm_mfma_unit(F, I, wsu, l, F.vcu / NGRP, F.vcu % NGRP); }
#endif
            }
            for (int rep = 0; rep < NREP(9); ++rep) {
                if (F.vcu >= BATCH * NGRP) { conv_pre_stage(F, I, l); const int nw = (F.G - BATCH * NGRP) * NWAVES, w0 = (F.vcu - BATCH * NGRP) * NWAVES + F.wave; for (int r = w0; r < M / 32; r += nw) conv_pre_run(F, I, l, r * 32); }
                if (F.G <= BATCH * NGRP) { conv_pre_stage(F, I, l); for (int r = gw; r < M / 32; r += NGW) conv_pre_run(F, I, l, r * 32); } }
            for (int rep = 0; rep < NREP(10); ++rep)
            for (int i = F.vcu; i < BATCH * NHEAD * NBLK; i += F.G) {
                const int j = i >> 8, v = i & 255, bh = v >> 2, c = v & 3, k = (j & 1) + 2 * c + 8 * (j >> 1); const int qb = (k & 1) ? 15 - (k >> 1) : (k >> 1);
#if ATTN_NAIVE
                attn_naive_unit(F, bh >> 3, bh & 7, qb);
#else
                { unsigned char* wsu = args.ws; asm volatile("" : "+s"(wsu));
                  const unsigned selbits = moba_gate(F, wsu, bh >> 3, bh & 7, qb);
                  attn_body::attn_unit<8>(bh >> 3, bh & 7, qb, selbits, (const attn_body::bf16*)(wsu + WS_QB), (const attn_body::bf16*)(wsu + WS_KB), (const attn_body::bf16*)(wsu + WS_VB), (attn_body::bf16*)(wsu + WS_MIX), (char*)lds + RING_OFF); }
#endif
            }
            if (BOTH(pb + 1)) GRID_BAR();
        }
        if (PHON(3) && IN(pb + 2)) { FRAME(); WL(); (void)wl;
            for (int rep = 0; rep < NREP(3); ++rep) {
            for (int r = gw; r < M; r += NGW) attn_norm_row(F, r);
            int K256 = 256; asm volatile("" : "+s"(K256));
            for (int i = F.vcu; i < 256; i += F.G) {
#ifndef TAIL_SKIP0
                if (i < 128) { pg8::Gemm g{(const bf16*)(F.ws + WS_Z), (const bf16*)(wl + WO_GLU), M, 256, K256}; pg8::OneUnit S{i, true};
                    pg8::EpiRowNorm<0> E{(const bf16*)(F.ws + WS_Z), I.p[12] + l * 256, MIX, 512};
                    pg8::gemm_phase<pg8::EpiRowNorm<0>, pg8::OneUnit, false, true>(F.lds + RING_OFF, g, S, E); }
#endif
#ifndef TAIL_SKIP1
                if (i >= 128) { pg8::Gemm g{(const bf16*)(F.ws + WS_YC), (const bf16*)(wl + WO_PW2), M, 256, K256}; pg8::OneUnit S{i - 128, true};
                    pg8::EpiRowNorm<1> E{nullptr, I.p[18] + l * 256, MIX, 768};
                    pg8::gemm_phase<pg8::EpiRowNorm<1>, pg8::OneUnit, false, true>(F.lds + RING_OFF, g, S, E); }
#endif
            }
            if (rep + 1 < NREP(3)) GRID_BAR(); }
            if (BOTH(pb + 2)) GRID_BAR();
        }
        if (PHON(4) && IN(pb + 3)) { FRAME(); WL(); (void)wl;
            pg8::Gemm g{MIX, (const bf16*)(wl + WO_OUT), M, DM, DM}; pg8::StaticOrder S; S.init(M, DM, F.G, (int)blockIdx.x);
            for (int rep = 0; rep < 1; ++rep) { pg8::EpiResid E{HB, SSQ};
            pg8::gemm_phase<pg8::EpiResid, pg8::StaticOrder, true, true>(F.lds + RING_OFF, g, S, E); }
            if (BOTH(pb + 3)) GRID_BAR();
        }
        if (PHON(5) && IN(pb + 4)) { FRAME(); WL(); (void)wl;
            pg8::Gemm g{HB, (const bf16*)(wl + WO_GU), M, D_GU, DM}; pg8::StaticOrder S; S.init(M, D_GU, F.G, (int)blockIdx.x);
            pg8::EpiSwiGlu E{SSQ, (bf16*)(F.ws + WS_ACT)};
            for (int rep = 0; rep < NREP(5); ++rep) { pg8::gemm_phase<pg8::EpiSwiGlu, pg8::StaticOrder, true, true>(F.lds + RING_OFF, g, S, E); if (rep + 1 < NREP(5)) GRID_BAR(); }
            if (BOTH(pb + 4)) GRID_BAR();
        }
        if (PHON(6) && IN(pb + 5)) { FRAME(); WL(); (void)wl;
            pg8::Gemm g{(const bf16*)(F.ws + WS_ACT), (const bf16*)(wl + WO_DN), M, DM, D_FF}; pg8::StaticOrder S; S.init(M, DM, F.G, (int)blockIdx.x);
            for (int rep = 0; rep < 1; ++rep) { pg8::EpiResid E{HB, SSQ};
            pg8::gemm_phase<pg8::EpiResid, pg8::StaticOrder, true, true>(F.lds + RING_OFF, g, S, E); }
            if (BOTH(pb + 5)) GRID_BAR();
        }
    }
    if (PHON(7) && IN(13)) { FRAME(); for (int r = gw; r < M; r += NGW) final_norm_row(F, args.out, I.p[26], r); }
#undef IN
#undef BOTH
}

typedef void (*kern_t)(Args);
static int phase_type(int p) { return p == 0 ? 0 : (p == 13 ? 7 : 1 + (p - 1) % 6); }
extern "C" void kernel_launch(void* const* d_in, const int* in_sizes, int n_in, void* d_out, int out_size, void* d_ws, size_t ws_size, hipStream_t stream) {
    static int grid = 0;
#if MK_ONE_LAUNCH
    static const kern_t kerns[1] = {skel_fwd<0xff>}; constexpr int NK = 1;
#else
    static const kern_t kerns[8] = {skel_fwd<0x01>, skel_fwd<0x02>, skel_fwd<0x04>, skel_fwd<0x08>, skel_fwd<0x10>, skel_fwd<0x20>, skel_fwd<0x40>, skel_fwd<0x80>}; constexpr int NK = 8;
#endif
    if (grid == 0) {
        if (n_in != 27 || out_size != M * DM || ws_size < WS_END) { fprintf(stderr, "kernel_launch: unexpected shapes: n_in %d out %d ws %zu\n", n_in, out_size, ws_size); grid = -1; return; }
        int dev = 0, cus = 0;
        if (hipGetDevice(&dev) != hipSuccess || hipDeviceGetAttribute(&cus, hipDeviceAttributeMultiprocessorCount, dev) != hipSuccess) { grid = -1; return; }
        for (int k = 0; k < NK; ++k) if (hipFuncSetAttribute((const void*)kerns[k], hipFuncAttributeMaxDynamicSharedMemorySize, LDS_BYTES) != hipSuccess) { fprintf(stderr, "kernel_launch: hipFuncSetAttribute failed\n"); grid = -1; return; }
        (void)hipGetLastError();
        grid = cus;
    }
    if (grid < 0) return;
    if (hipMemsetAsync((char*)d_ws + WS_CTL, 0, CTL_ZERO_BYTES, stream) != hipSuccess) return;
    Args a{};
    for (int i = 0; i < 27; ++i) a.in.p[i] = (const float*)d_in[i];
    a.out = (float*)d_out; a.ws = (unsigned char*)d_ws;
#if MK_ONE_LAUNCH
    a.ph_lo = 0; a.ph_hi = N_PHASES; a.li = 0; hipLaunchKernelGGL(kerns[0], dim3(grid), dim3(NWAVES * 64), LDS_BYTES, stream, a);
#else
    for (int p = 0; p < N_PHASES; ++p) { a.ph_lo = p; a.ph_hi = p + 1; a.li = p; hipLaunchKernelGGL(kerns[phase_type(p)], dim3(grid), dim3(NWAVES * 64), LDS_BYTES, stream, a); }
#endif
}
```

```cpp
#include <hip/hip_runtime.h>
#include <cstdio>
#include <cstdint>
namespace pg8 {
#define PG8_LAS __attribute__((address_space(3)))
typedef unsigned short bf16_t;
typedef short bf16x8 __attribute__((ext_vector_type(8)));
typedef float f32x4 __attribute__((ext_vector_type(4)));
typedef unsigned u32x4 __attribute__((ext_vector_type(4)));
constexpr int BM = 256, BK = 64, HALF = 128, HTB = HALF * BK * 2  , STAGE_BYTES = 8 * HTB, NXCD = 8, WGM = 8;

__host__ __device__ __forceinline__ int lds_byte(int r, int c) { const int st = (r >> 4) * 2 + (c >> 5), rr = r & 15, cc = c & 31, ob = rr * 64 + cc * 2; return st * 1024 + (ob ^ (((ob >> 9) & 1) << 5)); }
__host__ __device__ __forceinline__ void stage_rc(int b, int& R, int& C) { const int st = b / 1024, sb = b % 1024, swz = sb ^ (((sb >> 9) & 1) << 5); R = (st >> 1) * 16 + swz / 64; C = (st & 1) * 32 + (swz % 64) / 2; }
__host__ __device__ __forceinline__ int perm32(int rho) { const int n = rho >> 4, i = rho & 15; return 8 * (i >> 2) + 4 * n + (i & 3); }

struct Unit { int pm, pn; };
struct Gemm { const bf16_t* A; const bf16_t* Bt; int M, N, K; };

struct StaticOrder {
    int nM, nN, nwg, G, c;
    __host__ __device__ void init(int M, int N, int G_, int c_) { nM = M / BM; nN = N / BM; nwg = nM * nN; G = G_; c = c_; }
    __host__ __device__ bool next(int i, Unit& u) const {
        const long L = (long)i * G + c; if (L >= nwg) return false;
        int wgid = (int)L; { const int q = nwg / NXCD, r = nwg % NXCD, xcd = wgid % NXCD, off = wgid / NXCD; wgid = (xcd < r ? xcd * (q + 1) : r * (q + 1) + (xcd - r) * q) + off; }
        const int nig = WGM * nN, gid = wgid / nig, fm = gid * WGM, gsz = (nM - fm) < WGM ? (nM - fm) : WGM;
        u.pm = fm + ((wgid % nig) % gsz); u.pn = (wgid % nig) / gsz; return true;
    }
    __device__ __forceinline__ void a_ready(const Unit&) const {}
    __device__ __forceinline__ void done(const Unit&) const {}
};

__device__ __forceinline__ unsigned cvt_pk_bf16(float lo, float hi) { unsigned r; asm volatile("v_cvt_pk_bf16_f32 %0, %1, %2" : "=v"(r) : "v"(lo), "v"(hi)); return r; }
typedef float f32x2 __attribute__((ext_vector_type(2)));
}

namespace mdl {
constexpr int BATCH = 8, SEQ = 4096, DM = 1024, M = BATCH * SEQ, DEPTH = 2;
constexpr int D_ATTN = 512, NHEAD = 8, HD = 64, D_SSM = 256, D_CONV = 256, NGRP = 16, GCH = 16, NST = 64, CWID = 31;
constexpr int D_IN = 2304, D_FF = 2816, D_GU = 5632, NBLK = SEQ / 256;
constexpr float RMS_EPS = 1e-6f, LN_EPS = 1e-5f;
constexpr float C2 = 0.125f * 1.4426950408889634f;
}

namespace pg8 {
typedef unsigned u32x2 __attribute__((ext_vector_type(2)));
__device__ __forceinline__ float shx(float v, int m, int lane) { return __builtin_bit_cast(float, __builtin_amdgcn_ds_bpermute((lane ^ m) << 2, __builtin_bit_cast(int, v))); }
__device__ __forceinline__ float row_rstd16(const float* ssq, int row, float inv_n, float eps) {
    const f32x4* p = (const f32x4*)(ssq + (size_t)row * 16); const f32x4 a = p[0], b = p[1], c = p[2], d = p[3];
    const float s = ((a[0] + a[1]) + (a[2] + a[3])) + ((b[0] + b[1]) + (b[2] + b[3])) + ((c[0] + c[1]) + (c[2] + c[3])) + ((d[0] + d[1]) + (d[2] + d[3]));
    return 1.0f / sqrtf(s * inv_n + eps);
}

__device__ __forceinline__ void rows_rstd(const float* ssq, int rowb, int fq, int ln, float inv_n, float eps, float (&rs)[2][4]) {
    f32x4 p[2][4];
#pragma unroll
    for (int ai = 0; ai < 2; ++ai)
#pragma unroll
        for (int m = 0; m < 4; ++m) p[ai][m] = *(const f32x4*)(ssq + (size_t)(rowb + ai * HALF + m * 16) * 16 + 4 * fq);
#pragma unroll
    for (int ai = 0; ai < 2; ++ai)
#pragma unroll
        for (int m = 0; m < 4; ++m) { float s = (p[ai][m][0] + p[ai][m][1]) + (p[ai][m][2] + p[ai][m][3]); s += shx(s, 16, ln); s += shx(s, 32, ln); rs[ai][m] = __builtin_amdgcn_rsqf(s * inv_n + eps); }
}
__device__ __forceinline__ float sigmoidf_(float x) { return __builtin_amdgcn_rcpf(1.0f + __builtin_amdgcn_exp2f(-1.4426950408889634f * x)); }

struct EpiInProj {
    static constexpr bool PERM = true, AFTER_DRAIN = false;
    const float* ssq; const float* rope; bf16_t *Qb, *Kb, *Vb, *Us, *Uc; float* Qf; float* kmp;
    __device__ __forceinline__ void operator()(const f32x4 (&acc)[2][2][4][2], const Unit& u, int wr, int wc, int fr, int fq) const {
        asm volatile("" : "+v"(fr), "+v"(fq)); const int ln = fq * 16 + fr;
        const int pn = u.pn, rowb = u.pm * BM + wr * 64 + fr, lcol = wc * 32 + fq * 8;
        float rsv[2][4]; rows_rstd(ssq, rowb, fq, ln, 1.0f / 1024.0f, mdl::RMS_EPS, rsv);
        const bool isq = pn < 2, isk = (pn == 2 || pn == 3);
        if (isq || isk) {
            const bool rotw = (wc & 1) == 0;
            const bool rot = rotw && fq < 2; const float sgn = fq == 0 ? -1.f : 1.f;
            f32x4 cs[2][2];
#pragma unroll
            for (int bj = 0; bj < 2; ++bj)
#pragma unroll
                for (int n = 0; n < 2; ++n) cs[bj][n] = (f32x4){0.f, 0.f, 0.f, 0.f};
            bf16_t* O = isq ? Qb : Kb; const int ct = isq ? pn : pn - 2;
            f32x4 rq[4];
            if (rotw) { const f32x4* rp = (const f32x4*)(rope + (size_t)(rowb & (mdl::SEQ - 1)) * 16); rq[0] = rp[0]; rq[1] = rp[1]; rq[2] = rp[2]; rq[3] = rp[3]; }
#pragma unroll
            for (int ai = 0; ai < 2; ++ai)
#pragma unroll
                for (int m = 0; m < 4; ++m) {
                    const int row = rowb + ai * HALF + m * 16; const float rs = rsv[ai][m];
                    f32x4 v[2][2];
#pragma unroll
                    for (int bj = 0; bj < 2; ++bj)
#pragma unroll
                        for (int n = 0; n < 2; ++n) v[bj][n] = acc[ai][bj][m][n] * rs;
                    if (rotw) {
                        const f32x4 r0 = rq[0], r1 = rq[1], r2 = rq[2], r3 = rq[3];
                        if (ai * 4 + m < 7) { const int g1 = ai * 4 + m + 1, rown = rowb + (g1 >> 2) * HALF + (g1 & 3) * 16;
                            const f32x4* rp = (const f32x4*)(rope + (size_t)(rown & (mdl::SEQ - 1)) * 16); rq[0] = rp[0]; rq[1] = rp[1]; rq[2] = rp[2]; rq[3] = rp[3]; }
                        const float cc[2][4] = {{r0[0], r0[2], r1[0], r1[2]}, {r2[0], r2[2], r3[0], r3[2]}}, ss[2][4] = {{r0[1], r0[3], r1[1], r1[3]}, {r2[1], r2[3], r3[1], r3[3]}};
#pragma unroll
                        for (int bj = 0; bj < 2; ++bj)
#pragma unroll
                            for (int n = 0; n < 2; ++n)
#pragma unroll
                                for (int i = 0; i < 4; ++i) { const float x = v[bj][n][i], p = shx(x, 16, ln); if (rot) v[bj][n][i] = x * cc[n][i] + sgn * p * ss[n][i]; }
                    }
#pragma unroll
                    for (int bj = 0; bj < 2; ++bj) {
                        const size_t off = (size_t)row * 512 + ct * 256 + bj * HALF + lcol;
                        const float sc = isq ? mdl::C2 : 1.0f;
                        u32x4 w; w.x = cvt_pk_bf16(v[bj][0][0] * sc, v[bj][0][1] * sc); w.y = cvt_pk_bf16(v[bj][0][2] * sc, v[bj][0][3] * sc); w.z = cvt_pk_bf16(v[bj][1][0] * sc, v[bj][1][1] * sc); w.w = cvt_pk_bf16(v[bj][1][2] * sc, v[bj][1][3] * sc);
                        *(u32x4*)(O + off) = w;
                        if (!isq) { cs[bj][0] += v[bj][0]; cs[bj][1] += v[bj][1]; }
                    }
                }
            if (isk) {
#pragma unroll
                for (int bj = 0; bj < 2; ++bj)
#pragma unroll
                    for (int n = 0; n < 2; ++n)
#pragma unroll
                        for (int i = 0; i < 4; ++i) { float s = cs[bj][n][i]; s += shx(s, 1, ln); s += shx(s, 2, ln); s += shx(s, 4, ln); s += shx(s, 8, ln); cs[bj][n][i] = s; }
                if (fr == 0) {
                    float* kp = kmp + ((size_t)(wr * mdl::BATCH * mdl::NBLK + u.pm) * 512) + ct * 256 + lcol;
#pragma unroll
                    for (int bj = 0; bj < 2; ++bj) { *(f32x4*)(kp + bj * HALF) = cs[bj][0]; *(f32x4*)(kp + bj * HALF + 4) = cs[bj][1]; }
                }
            }
        } else if (pn < 7) {
            bf16_t* O = pn == 6 ? Us : Vb; const int ld = pn == 6 ? 256 : 512, ct = pn == 6 ? 0 : pn - 4;
#pragma unroll
            for (int ai = 0; ai < 2; ++ai)
#pragma unroll
                for (int m = 0; m < 4; ++m) {
                    const int row = rowb + ai * HALF + m * 16; const float rs = rsv[ai][m];
#pragma unroll
                    for (int bj = 0; bj < 2; ++bj) { const f32x4 v0 = acc[ai][bj][m][0] * rs, v1 = acc[ai][bj][m][1] * rs;
                        u32x4 w; w.x = cvt_pk_bf16(v0[0], v0[1]); w.y = cvt_pk_bf16(v0[2], v0[3]); w.z = cvt_pk_bf16(v1[0], v1[1]); w.w = cvt_pk_bf16(v1[2], v1[3]);
                        *(u32x4*)(O + (size_t)row * ld + ct * 256 + bj * HALF + lcol) = w; }
                }
        } else {
            const int ct = pn - 7;
#pragma unroll
            for (int ai = 0; ai < 2; ++ai)
#pragma unroll
                for (int m = 0; m < 4; ++m) {
                    const int row = rowb + ai * HALF + m * 16; const float rs = rsv[ai][m];
                    float o[8];
#pragma unroll
                    for (int n = 0; n < 2; ++n)
#pragma unroll
                        for (int i = 0; i < 4; ++i) { const float a = acc[ai][0][m][n][i] * rs, g = acc[ai][1][m][n][i] * rs; o[n * 4 + i] = a * sigmoidf_(g); }
                    u32x4 w; w.x = cvt_pk_bf16(o[0], o[1]); w.y = cvt_pk_bf16(o[2], o[3]); w.z = cvt_pk_bf16(o[4], o[5]); w.w = cvt_pk_bf16(o[6], o[7]);
                    *(u32x4*)(Uc + (size_t)row * 256 + ct * HALF + lcol) = w;
                }
        }
    }
};

struct EpiResid {
    static constexpr bool PERM = true, AFTER_DRAIN = false;
    bf16_t* hb; float* ssq;
    __device__ __forceinline__ void operator()(const f32x4 (&acc)[2][2][4][2], const Unit& u, int wr, int wc, int fr, int fq) const {
        asm volatile("" : "+v"(fr), "+v"(fq)); const int ln = fq * 16 + fr;
        const int col0 = u.pn * BM + wc * 32 + 8 * fq;
        u32x4 pre[4][2], nxt[4][2];
#pragma unroll
        for (int m = 0; m < 4; ++m)
#pragma unroll
            for (int bj = 0; bj < 2; ++bj) pre[m][bj] = *(const u32x4*)(hb + (size_t)(u.pm * BM + wr * 64 + m * 16 + fr) * mdl::DM + col0 + bj * HALF);
#pragma unroll
        for (int ai = 0; ai < 2; ++ai) {
#pragma unroll
            for (int m = 0; m < 4; ++m) {
                const int row = u.pm * BM + ai * HALF + wr * 64 + m * 16 + fr; bf16_t* hp = hb + (size_t)row * mdl::DM + col0; float s = 0.f;
#pragma unroll
                for (int bj = 0; bj < 2; ++bj) {
                    const u32x4 b = pre[m][bj];
                    const f32x4 o0 = acc[ai][bj][m][0] + (f32x4){__uint_as_float(b.x << 16), __uint_as_float(b.x & 0xffff0000u), __uint_as_float(b.y << 16), __uint_as_float(b.y & 0xffff0000u)};
                    const f32x4 o1 = acc[ai][bj][m][1] + (f32x4){__uint_as_float(b.z << 16), __uint_as_float(b.z & 0xffff0000u), __uint_as_float(b.w << 16), __uint_as_float(b.w & 0xffff0000u)};
                    s += (o0[0] * o0[0] + o0[1] * o0[1]) + (o0[2] * o0[2] + o0[3] * o0[3]) + (o1[0] * o1[0] + o1[1] * o1[1]) + (o1[2] * o1[2] + o1[3] * o1[3]);
                    u32x4 w; w.x = cvt_pk_bf16(o0[0], o0[1]); w.y = cvt_pk_bf16(o0[2], o0[3]); w.z = cvt_pk_bf16(o1[0], o1[1]); w.w = cvt_pk_bf16(o1[2], o1[3]);
                    *(u32x4*)(hp + bj * HALF) = w; }
                s += shx(s, 16, ln); s += shx(s, 32, ln);
                if (fq == 0) ssq[(size_t)row * 16 + u.pn * 4 + wc] = s;
                if (ai == 0 && m == 0) {
#pragma unroll
                    for (int m2 = 0; m2 < 4; ++m2)
#pragma unroll
                        for (int bj = 0; bj < 2; ++bj) nxt[m2][bj] = *(const u32x4*)(hb + (size_t)(u.pm * BM + HALF + wr * 64 + m2 * 16 + fr) * mdl::DM + col0 + bj * HALF);
                }
            }
#pragma unroll
            for (int m = 0; m < 4; ++m)
#pragma unroll
                for (int bj = 0; bj < 2; ++bj) pre[m][bj] = nxt[m][bj];
        }
    }
};

struct EpiSwiGlu {
    static constexpr bool PERM = true, AFTER_DRAIN = false;
    const float* ssq; bf16_t* act;
    __device__ __forceinline__ void operator()(const f32x4 (&acc)[2][2][4][2], const Unit& u, int wr, int wc, int fr, int fq) const {
        asm volatile("" : "+v"(fr), "+v"(fq)); const int ln = fq * 16 + fr;
        const int col0 = u.pn * HALF + wc * 32 + fq * 8;
        float rsv[2][4]; rows_rstd(ssq, u.pm * BM + wr * 64 + fr, fq, ln, 1.0f / 1024.0f, mdl::RMS_EPS, rsv);
#pragma unroll
        for (int ai = 0; ai < 2; ++ai)
#pragma unroll
            for (int m = 0; m < 4; ++m) {
                const int row = u.pm * BM + ai * HALF + wr * 64 + m * 16 + fr; const float rs = rsv[ai][m];
                float o[8];
#pragma unroll
                for (int n = 0; n < 2; ++n)
#pragma unroll
                    for (int i = 0; i < 4; ++i) { const float g = acc[ai][0][m][n][i] * rs, up = acc[ai][1][m][n][i] * rs; o[n * 4 + i] = g * sigmoidf_(g) * up; }
                u32x4 w; w.x = cvt_pk_bf16(o[0], o[1]); w.y = cvt_pk_bf16(o[2], o[3]); w.z = cvt_pk_bf16(o[4], o[5]); w.w = cvt_pk_bf16(o[6], o[7]);
                *(u32x4*)(act + (size_t)row * mdl::D_FF + col0) = w;
            }
    }
};

template <int MODE> struct EpiRowNorm {
    static constexpr bool PERM = true, AFTER_DRAIN = true;
    const bf16_t* z; const float* bias; bf16_t* out; int ocol;
    __device__ __forceinline__ void fused(f32x4 (&acc)[2][2][4][2], const Unit& u, int wr, int wc, int fr, int fq, PG8_LAS unsigned char* lds, int wid, int lane) const {
        asm volatile("" : "+v"(fr), "+v"(fq)); const int ln = fq * 16 + fr;
        PG8_LAS float* P = (PG8_LAS float*)lds;
        const int lcol = wc * 32 + fq * 8;
        f32x4 bv[2][2];
#pragma unroll
        for (int bj = 0; bj < 2; ++bj)
#pragma unroll
            for (int n = 0; n < 2; ++n) bv[bj][n] = *(const f32x4*)(bias + bj * HALF + lcol + 4 * n);
        u32x4 zpre[2][4][2];
        if (MODE == 0) {
#pragma unroll
            for (int ai = 0; ai < 2; ++ai)
#pragma unroll
                for (int m = 0; m < 4; ++m)
#pragma unroll
                    for (int bj = 0; bj < 2; ++bj) zpre[ai][m][bj] = *(const u32x4*)(z + (size_t)(u.pm * BM + ai * HALF + wr * 64 + m * 16 + fr) * 256 + bj * HALF + lcol);
        }
#pragma unroll
        for (int ai = 0; ai < 2; ++ai)
#pragma unroll
            for (int m = 0; m < 4; ++m) {
                const int lrow = ai * HALF + wr * 64 + m * 16 + fr, row = u.pm * BM + lrow; float s = 0.f;
#pragma unroll
                for (int bj = 0; bj < 2; ++bj) {
                    f32x4 v0 = acc[ai][bj][m][0] + bv[bj][0], v1 = acc[ai][bj][m][1] + bv[bj][1];
                    if (MODE == 0) {
                        const u32x4 zz = zpre[ai][m][bj];
                        const float z0 = __uint_as_float(zz.x << 16), z1 = __uint_as_float(zz.x & 0xffff0000u), z2 = __uint_as_float(zz.y << 16), z3 = __uint_as_float(zz.y & 0xffff0000u);
                        const float z4 = __uint_as_float(zz.z << 16), z5 = __uint_as_float(zz.z & 0xffff0000u), z6 = __uint_as_float(zz.w << 16), z7 = __uint_as_float(zz.w & 0xffff0000u);
                        v0 = (f32x4){z0 * sigmoidf_(v0[0]), z1 * sigmoidf_(v0[1]), z2 * sigmoidf_(v0[2]), z3 * sigmoidf_(v0[3])};
                        v1 = (f32x4){z4 * sigmoidf_(v1[0]), z5 * sigmoidf_(v1[1]), z6 * sigmoidf_(v1[2]), z7 * sigmoidf_(v1[3])};
                    }
                    acc[ai][bj][m][0] = v0; acc[ai][bj][m][1] = v1;
                    s += (v0[0] * v0[0] + v0[1] * v0[1]) + (v0[2] * v0[2] + v0[3] * v0[3]) + (v1[0] * v1[0] + v1[1] * v1[1]) + (v1[2] * v1[2] + v1[3] * v1[3]);
                }
                s += shx(s, 16, ln); s += shx(s, 32, ln);
                if (fq == 0) P[lrow * 4 + wc] = s;
                asm volatile("" ::: "memory");
            }
        asm volatile("s_waitcnt lgkmcnt(0)" ::: "memory"); __builtin_amdgcn_s_barrier(); asm volatile("" ::: "memory");
#pragma unroll
        for (int ai = 0; ai < 2; ++ai)
#pragma unroll
            for (int m = 0; m < 4; ++m) {
                const int lrow = ai * HALF + wr * 64 + m * 16 + fr, row = u.pm * BM + lrow;
                const f32x4 pp = *(const PG8_LAS f32x4*)(P + lrow * 4); const float rs = __builtin_amdgcn_rsqf(((pp[0] + pp[1]) + (pp[2] + pp[3])) * (1.0f / 256.0f) + mdl::RMS_EPS);
#pragma unroll
                for (int bj = 0; bj < 2; ++bj) { const f32x4 v0 = acc[ai][bj][m][0] * rs, v1 = acc[ai][bj][m][1] * rs;
                    u32x4 w; w.x = cvt_pk_bf16(v0[0], v0[1]); w.y = cvt_pk_bf16(v0[2], v0[3]); w.z = cvt_pk_bf16(v1[0], v1[1]); w.w = cvt_pk_bf16(v1[2], v1[3]);
                    *(u32x4*)(out + (size_t)row * mdl::DM + ocol + bj * HALF + lcol) = w; }
                asm volatile("" ::: "memory");
            }
        asm volatile("s_waitcnt lgkmcnt(0)" ::: "memory"); __builtin_amdgcn_s_barrier(); asm volatile("" ::: "memory");
    }
};

struct EpiNull {
    static constexpr bool PERM = true, AFTER_DRAIN = false;
    float* dummy;
    __device__ __forceinline__ void operator()(const f32x4 (&acc)[2][2][4][2], const Unit& u, int wr, int wc, int fr, int fq) const {
        f32x4 s = (f32x4){0.f, 0.f, 0.f, 0.f};
#pragma unroll
        for (int ai = 0; ai < 2; ++ai)
#pragma unroll
            for (int bj = 0; bj < 2; ++bj)
#pragma unroll
                for (int m = 0; m < 4; ++m)
#pragma unroll
                    for (int n = 0; n < 2; ++n) s += acc[ai][bj][m][n];
        *(f32x4*)(dummy + ((size_t)(blockIdx.x * 8 + wr * 4 + wc) * 64 + fq * 16 + fr) * 4) = s;
    }
};
struct OneUnit {
    int pm; bool on;
    __device__ __forceinline__ bool next(int i, Unit& u) const { if (i > 0 || !on) return false; u.pm = pm; u.pn = 0; return true; }
    __device__ __forceinline__ void a_ready(const Unit&) const {}
    __device__ __forceinline__ void done(const Unit&) const {}
};
}
namespace pg8 {
template <class Epi, class Sched, bool ALIGN_EPI = false, bool SP2 = false>
__device__ __forceinline__ void gemm_phase(PG8_LAS unsigned char* lds, const Gemm g, const Sched& S, const Epi& E) {
    int tid_ = threadIdx.x; asm volatile("" : "+v"(tid_));
    const int tid = tid_, wid = __builtin_amdgcn_readfirstlane(tid >> 6), lane = tid & 63, wr = wid >> 2, wc = wid & 3, fr = lane & 15, fq = lane >> 4;
    const int K = g.K, nt = K / BK;
    unsigned voffA[2], voffB[2];
#pragma unroll
    for (int i = 0; i < 2; ++i) { int R, C; stage_rc(tid * 16 + i * 8192, R, C); const int Rb = Epi::PERM ? ((R & ~31) + perm32(R & 31)) : R;
        voffA[i] = (unsigned)(R * K + C) * 2u; voffB[i] = (unsigned)(Rb * K + C) * 2u; }
    const size_t kstep = (size_t)(BK * 2);
    const size_t hstep = (size_t)HALF * K * 2;
    const size_t tstep = 2 * hstep;
    const unsigned ldsw = (unsigned)wid * 1024u;
    const int aoff = lds_byte(wr * 64 + fr, fq * 8), boff = lds_byte(wc * 32 + fr, fq * 8);
#define PG8_SA(b, h) (((b) * 2 + (h)) * HTB)
#define PG8_SB(b, h) ((4 + (b) * 2 + (h)) * HTB)
#define PG8_STAGE(bufoff, gbase, voff) do { _Pragma("unroll") for (int _i = 0; _i < 2; ++_i) \
        __builtin_amdgcn_global_load_lds((const unsigned*)((const char*)(gbase) + (voff)[_i]), (PG8_LAS unsigned*)(lds + (bufoff) + ldsw + _i * 8192), 16, 0, 0); } while (0)
#define PG8_LDA(dst, b, h) do { _Pragma("unroll") for (int m = 0; m < 4; ++m) _Pragma("unroll") for (int k = 0; k < 2; ++k) dst[m][k] = *(const PG8_LAS bf16x8*)(lds + PG8_SA(b, h) + aoff + m * 2048 + k * 1024); } while (0)
#define PG8_LDB(dst, b, h) do { _Pragma("unroll") for (int n = 0; n < 2; ++n) _Pragma("unroll") for (int k = 0; k < 2; ++k) dst[n][k] = *(const PG8_LAS bf16x8*)(lds + PG8_SB(b, h) + boff + n * 2048 + k * 1024); } while (0)
#define PG8_MMA(ai, bj, At, Bt) do { __builtin_amdgcn_s_setprio(1); _Pragma("unroll") for (int m = 0; m < 4; ++m) _Pragma("unroll") for (int n = 0; n < 2; ++n) _Pragma("unroll") for (int k = 0; k < 2; ++k) \
        acc[ai][bj][m][n] = __builtin_amdgcn_mfma_f32_16x16x32_bf16(Bt[n][k], At[m][k], acc[ai][bj][m][n], 0, 0, 0); __builtin_amdgcn_s_setprio(0); } while (0)
#define PG8_WAIT_V(n) asm volatile("s_waitcnt vmcnt(" #n ")" ::: "memory")
#define PG8_WAIT_L(n) asm volatile("s_waitcnt lgkmcnt(" #n ")" ::: "memory")
#define PG8_BAR __builtin_amdgcn_s_barrier()
#define PG8_SCHED __builtin_amdgcn_sched_barrier(0)
    Unit cur, nxt; int ui = 0;
    if (!S.next(0, cur)) return;
    f32x4 acc[2][2][4][2];
#pragma unroll
    for (int a = 0; a < 2; ++a)
#pragma unroll
        for (int b = 0; b < 2; ++b)
#pragma unroll
            for (int m = 0; m < 4; ++m)
#pragma unroll
                for (int n = 0; n < 2; ++n) acc[a][b][m][n] = (f32x4){0.f, 0.f, 0.f, 0.f};
    bf16x8 At[4][2], B0[2][2], B1[2][2];
    const char* cA = (const char*)g.A + (size_t)cur.pm * tstep; const char* cB = (const char*)g.Bt + (size_t)cur.pn * tstep;
    S.a_ready(cur);
    if constexpr (SP2) {
        PG8_STAGE(PG8_SB(0, 0), cB, voffB); PG8_STAGE(PG8_SB(0, 1), cB + hstep, voffB); PG8_STAGE(PG8_SA(0, 0), cA, voffA); PG8_STAGE(PG8_SA(0, 1), cA + hstep, voffA);
        if (wr == 1) PG8_BAR;
        PG8_WAIT_V(2); PG8_BAR;
        PG8_STAGE(PG8_SB(1, 0), cB + kstep, voffB); PG8_STAGE(PG8_SA(1, 0), cA + kstep, voffA); PG8_STAGE(PG8_SB(1, 1), cB + hstep + kstep, voffB);
        PG8_WAIT_V(6); PG8_BAR;
    } else {
        PG8_STAGE(PG8_SB(0, 0), cB, voffB); PG8_STAGE(PG8_SA(0, 0), cA, voffA); PG8_STAGE(PG8_SB(0, 1), cB + hstep, voffB); PG8_STAGE(PG8_SA(0, 1), cA + hstep, voffA);
        if (wr == 1) PG8_BAR;
        PG8_WAIT_V(4); PG8_BAR;
        PG8_STAGE(PG8_SB(1, 0), cB + kstep, voffB); PG8_STAGE(PG8_SA(1, 0), cA + kstep, voffA); PG8_STAGE(PG8_SB(1, 1), cB + hstep + kstep, voffB);
        PG8_WAIT_V(6); PG8_BAR;
    }
    for (;;) {
        const bool has_next = S.next(ui + 1, nxt);
        const char* nA = has_next ? (const char*)g.A + (size_t)nxt.pm * tstep : cA; const char* nB = has_next ? (const char*)g.Bt + (size_t)nxt.pn * tstep : cB;
        for (int t = 0; t < nt; t += 2) {
            const bool last = (t == nt - 2);
            const char* a1 = cA + (size_t)(t + 1) * kstep;
            const char* a2 = last ? nA : cA + (size_t)(t + 2) * kstep; const char* b2 = last ? nB : cB + (size_t)(t + 2) * kstep;
            const char* a3 = a2 + kstep; const char* b3 = b2 + kstep;
            if (last && has_next) S.a_ready(nxt);
            if constexpr (SP2) {
            PG8_LDB(B0, 0, 0); PG8_LDB(B1, 0, 1); PG8_SCHED; PG8_LDA(At, 0, 0); PG8_STAGE(PG8_SA(1, 1), a1 + hstep, voffA);
            PG8_WAIT_V(8); PG8_WAIT_L(0); PG8_BAR; PG8_MMA(0, 0, At, B0); PG8_MMA(0, 1, At, B1); PG8_BAR; PG8_SCHED;
            PG8_LDA(At, 0, 1); PG8_STAGE(PG8_SB(0, 0), b2, voffB); PG8_STAGE(PG8_SB(0, 1), b2 + hstep, voffB); PG8_STAGE(PG8_SA(0, 0), a2, voffA);
            PG8_WAIT_V(8); PG8_WAIT_L(0); PG8_BAR; PG8_MMA(1, 0, At, B0); PG8_MMA(1, 1, At, B1); PG8_BAR; PG8_SCHED;
            PG8_LDB(B0, 1, 0); PG8_LDB(B1, 1, 1); PG8_SCHED; PG8_LDA(At, 1, 0); PG8_STAGE(PG8_SA(0, 1), a2 + hstep, voffA);
            PG8_WAIT_V(8); PG8_WAIT_L(0); PG8_BAR; PG8_MMA(0, 0, At, B0); PG8_MMA(0, 1, At, B1); PG8_BAR; PG8_SCHED;
            PG8_LDA(At, 1, 1); PG8_STAGE(PG8_SB(1, 0), b3, voffB); PG8_STAGE(PG8_SB(1, 1), b3 + hstep, voffB); PG8_STAGE(PG8_SA(1, 0), a3, voffA);
            PG8_WAIT_V(8); PG8_WAIT_L(0); PG8_BAR; PG8_MMA(1, 0, At, B0); PG8_MMA(1, 1, At, B1); PG8_BAR; PG8_SCHED;
            } else {
            PG8_LDB(B0, 0, 0); PG8_SCHED; PG8_LDA(At, 0, 0); PG8_STAGE(PG8_SA(1, 1), a1 + hstep, voffA);
            PG8_WAIT_L(8); PG8_BAR; PG8_WAIT_L(0); PG8_MMA(0, 0, At, B0); PG8_BAR; PG8_SCHED;
            PG8_LDB(B1, 0, 1); PG8_STAGE(PG8_SB(0, 0), b2, voffB);
            PG8_BAR; PG8_WAIT_L(0); PG8_MMA(0, 1, At, B1); PG8_BAR;
            PG8_LDA(At, 0, 1); PG8_STAGE(PG8_SA(0, 0), a2, voffA);
            PG8_BAR; PG8_WAIT_L(0); PG8_MMA(1, 0, At, B0); PG8_BAR; PG8_SCHED;
            PG8_STAGE(PG8_SB(0, 1), b2 + hstep, voffB);
            PG8_WAIT_V(6); PG8_BAR; PG8_MMA(1, 1, At, B1); PG8_BAR;
            PG8_LDB(B0, 1, 0); PG8_SCHED; PG8_LDA(At, 1, 0); PG8_STAGE(PG8_SA(0, 1), a2 + hstep, voffA);
            PG8_WAIT_L(8); PG8_BAR; PG8_WAIT_L(0); PG8_MMA(0, 0, At, B0); PG8_BAR; PG8_SCHED;
            PG8_LDB(B1, 1, 1); PG8_STAGE(PG8_SB(1, 0), b3, voffB);
            PG8_BAR; PG8_WAIT_L(0); PG8_MMA(0, 1, At, B1); PG8_BAR;
            PG8_LDA(At, 1, 1); PG8_STAGE(PG8_SA(1, 0), a3, voffA);
            PG8_BAR; PG8_WAIT_L(0); PG8_MMA(1, 0, At, B0); PG8_BAR; PG8_SCHED;
            PG8_STAGE(PG8_SB(1, 1), b3 + hstep, voffB);
            PG8_WAIT_V(6); PG8_BAR; PG8_MMA(1, 1, At, B1); PG8_BAR;
            }
        }
        if constexpr (ALIGN_EPI) { if (wr == 0) PG8_BAR; }
        if constexpr (!Epi::AFTER_DRAIN) { E(acc, cur, wr, wc, fr, fq); S.done(cur); }
        if (!has_next) break;
#pragma unroll
        for (int a = 0; a < 2; ++a)
#pragma unroll
            for (int b = 0; b < 2; ++b)
#pragma unroll
                for (int m = 0; m < 4; ++m)
#pragma unroll
                    for (int n = 0; n < 2; ++n) acc[a][b][m][n] = (f32x4){0.f, 0.f, 0.f, 0.f};
        cur = nxt; cA = nA; cB = nB; ++ui;
        if constexpr (ALIGN_EPI) { if (wr == 1) PG8_BAR; }
    }
    PG8_WAIT_V(0);
    if constexpr (!ALIGN_EPI) { if (wr == 0) PG8_BAR; }
    PG8_BAR;
    if constexpr (Epi::AFTER_DRAIN) { E.fused(acc, cur, wr, wc, fr, fq, lds, wid, lane); S.done(cur); }
#undef PG8_SA
#undef PG8_SB
#undef PG8_STAGE
#undef PG8_LDA
#undef PG8_LDB
#undef PG8_MMA
#undef PG8_WAIT_V
#undef PG8_WAIT_L
#undef PG8_BAR
#undef PG8_SCHED
}
}
#include <hip/hip_bf16.h>
#include <cmath>
namespace attn_body {
using bf16=__hip_bfloat16;
using bf16x8=__attribute__((ext_vector_type(8)))short;
using s16x4=__attribute__((ext_vector_type(4)))short;
using f32x16=__attribute__((ext_vector_type(16)))float;
using u32x4=__attribute__((ext_vector_type(4)))unsigned;
constexpr int BATCH=8,NHEAD=8,SEQ=4096,D=64,DM=NHEAD*D,OP=1024;
constexpr int NW=8,QBLK=32,QB=QBLK*NW,KVBLK=64,NQB=SEQ/QB;
constexpr int ATTN_PITCH=DM, ATTN_UNIT_ROWS=QB;
__device__ __forceinline__ int crow(int r,int hi){return (r&3)+8*(r>>2)+4*hi;}
#define SBAR() __builtin_amdgcn_sched_barrier(0)
__device__ __forceinline__ void cmask(f32x16&p0,f32x16&p1,int jb,int qrel,int hi){
  const float NEG=-INFINITY; int kb=64*jb+4*hi;
  #pragma unroll
  for(int r=0;r<16;++r){int kv=kb+(r&3)+8*(r>>2); if(kv>qrel)p0[r]=NEG; if(kv+32>qrel)p1[r]=NEG;}
}

constexpr int NSLOT=3, SLOTB=8192;
constexpr int LDS_K=0, LDS_V=NSLOT*SLOTB, LDS_WS=2*NSLOT*SLOTB, LDS_OST=LDS_WS+NW*64*4, LDS_BYTES=LDS_OST+NW*4096;
constexpr float C2=0.125f*1.4426950408889634f;
__device__ __forceinline__ void glds16(const void*gsrc,unsigned lds_dst){unsigned keep;
  asm volatile("s_mov_b32 %0, m0\n\ts_mov_b32 m0, %2\n\ts_nop 0\n\tglobal_load_lds_dwordx4 %1, off\n\ts_mov_b32 m0, %0":"=&s"(keep):"v"(gsrc),"s"(lds_dst):"memory");}
__device__ __forceinline__ float max3f(float a,float b,float c){float r;asm("v_max3_f32 %0, %1, %2, %3":"=v"(r):"v"(a),"v"(b),"v"(c));return r;}
__device__ __forceinline__ float max2f(float a,float b){float r;asm("v_max_f32_e32 %0, %1, %2":"=v"(r):"v"(a),"v"(b));return r;}
__device__ __forceinline__ float fadd_s(float a,float b){float r;asm("v_add_f32_e32 %0, %1, %2":"=v"(r):"v"(a),"v"(b));return r;}
__device__ __forceinline__ float fsub_s(float a,float b){float r;asm("v_sub_f32_e32 %0, %1, %2":"=v"(r):"v"(a),"v"(b));return r;}
typedef float f32x2_t __attribute__((ext_vector_type(2))); typedef __bf16 bf16x2_t __attribute__((ext_vector_type(2)));
__device__ __forceinline__ unsigned cvtpk_s(float lo,float hi){f32x2_t v={lo,hi};bf16x2_t b=__builtin_convertvector(v,bf16x2_t);return __builtin_bit_cast(unsigned,b);}
#define WAIT_BAR(N) asm volatile("s_waitcnt vmcnt(" #N ") lgkmcnt(0)\n\ts_barrier":::"memory")

__device__ __forceinline__ void qkt(f32x16&p0,f32x16&p1,const char*Kslot,const bf16x8*qr,const f32x16&negm,int r32,int hi){
  const char*kb=Kslot+hi*1024+r32*16;
  #pragma unroll
  for(int d0=0;d0<4;++d0){
    const bf16x8 b0=*reinterpret_cast<const bf16x8*>(kb+d0*2048);
    const bf16x8 b1=*reinterpret_cast<const bf16x8*>(kb+d0*2048+512);
    if(d0==0){p0=__builtin_amdgcn_mfma_f32_32x32x16_bf16(b0,qr[0],negm,0,0,0);p1=__builtin_amdgcn_mfma_f32_32x32x16_bf16(b1,qr[0],negm,0,0,0);}
    else{p0=__builtin_amdgcn_mfma_f32_32x32x16_bf16(b0,qr[d0],p0,0,0,0);p1=__builtin_amdgcn_mfma_f32_32x32x16_bf16(b1,qr[d0],p1,0,0,0);}}
}
typedef __attribute__((address_space(3))) const char* lds_cptr;
typedef short v4i16_t __attribute__((ext_vector_type(4)));
__device__ __forceinline__ void kload8(bf16x8*kf,lds_cptr kp){
  kf[0]=*(const __attribute__((address_space(3))) bf16x8*)(kp);      kf[1]=*(const __attribute__((address_space(3))) bf16x8*)(kp+512);
  kf[2]=*(const __attribute__((address_space(3))) bf16x8*)(kp+2048); kf[3]=*(const __attribute__((address_space(3))) bf16x8*)(kp+2560);
  kf[4]=*(const __attribute__((address_space(3))) bf16x8*)(kp+4096); kf[5]=*(const __attribute__((address_space(3))) bf16x8*)(kp+4608);
  kf[6]=*(const __attribute__((address_space(3))) bf16x8*)(kp+6144); kf[7]=*(const __attribute__((address_space(3))) bf16x8*)(kp+6656);
}
__device__ __forceinline__ void kload2(bf16x8*kf,lds_cptr kp,int j){ kf[2*j]=*(const __attribute__((address_space(3))) bf16x8*)(kp+j*2048); kf[2*j+1]=*(const __attribute__((address_space(3))) bf16x8*)(kp+j*2048+512); }
__device__ __forceinline__ s16x4 vtr(lds_cptr p){ return __builtin_bit_cast(s16x4,__builtin_amdgcn_ds_read_tr16_b64_v4i16((__attribute__((address_space(3))) v4i16_t*)p)); }
__device__ __forceinline__ float rowmax(const f32x16&p0,const f32x16&p1){
  float a=max3f(p0[0],p0[1],p1[0]),b=max3f(p0[2],p0[3],p1[1]);a=max3f(a,p1[2],p1[3]);
  #pragma unroll
  for(int r=4;r<16;r+=4){a=max3f(a,p0[r],p0[r+1]);b=max3f(b,p0[r+2],p0[r+3]);a=max3f(a,p1[r],p1[r+1]);b=max3f(b,p1[r+2],p1[r+3]);}
  const float m=max2f(a,b);
  auto rr=__builtin_amdgcn_permlane32_swap(__float_as_uint(m),__float_as_uint(m),false,false);
  return max2f(__uint_as_float(rr[0]),__uint_as_float(rr[1]));
}
__device__ __forceinline__ void pv(f32x16*o,int vb,bf16x8 pa0,bf16x8 pa1,bf16x8 pa2,bf16x8 pa3){
  #pragma unroll
  for(int d0=0;d0<2;++d0){s16x4 lo[4],hi[4];
    #pragma unroll
    for(int ks=0;ks<4;++ks){
      asm volatile("ds_read_b64_tr_b16 %0,%1 offset:%c2":"=&v"(lo[ks]):"v"(vb),"i"(d0*4096+ks*1024):"memory");
      asm volatile("ds_read_b64_tr_b16 %0,%1 offset:%c2":"=&v"(hi[ks]):"v"(vb),"i"(d0*4096+ks*1024+512):"memory");}
    asm volatile("s_waitcnt lgkmcnt(0)":::"memory");SBAR();
    #define PK(k) (bf16x8){lo[k][0],lo[k][1],lo[k][2],lo[k][3],hi[k][0],hi[k][1],hi[k][2],hi[k][3]}
    o[d0]=__builtin_amdgcn_mfma_f32_32x32x16_bf16(pa0,PK(0),o[d0],0,0,0);
    o[d0]=__builtin_amdgcn_mfma_f32_32x32x16_bf16(pa1,PK(1),o[d0],0,0,0);
    o[d0]=__builtin_amdgcn_mfma_f32_32x32x16_bf16(pa2,PK(2),o[d0],0,0,0);
    o[d0]=__builtin_amdgcn_mfma_f32_32x32x16_bf16(pa3,PK(3),o[d0],0,0,0);
    #undef PK
  }
}

#ifndef ATTN_STORE16
#define ATTN_STORE16(p,v) (*(u32x4*)(p)=(v))
#endif
#define KT(s) ((s)<4?4*qb+(s):(s)-4)
template<int THRL> __device__ __forceinline__ void attn_unit(int b,int h,int qb,unsigned selbits,const bf16*Q,const bf16*__restrict__ K,const bf16*__restrict__ V,bf16*O,char*shm){
  int tid_=threadIdx.x; asm volatile("":"+v"(tid_));
  const int tid=tid_,lane=tid&63,r32=lane&31,hi=lane>>5; const int wid=__builtin_amdgcn_readfirstlane(tid>>6);
  const long rowbase=(long)b*SEQ; const int q0=qb*QB;
  const bf16*Qw=Q+(rowbase+q0+wid*QBLK)*DM+h*D;
  const bf16*Kh=K+rowbase*DM+h*D,*Vh=V+rowbase*DM+h*D;
  const unsigned lds0=(unsigned)(uintptr_t)shm;
  float*wsf=(float*)(shm+LDS_WS)+wid*64;
  const bf16*ksrc=Kh+(long)lane*DM+wid*8;
  const bf16*vsrc=Vh+(long)(16*(wid&3)+(lane>>2))*DM+(wid>>2)*32+(lane&3)*8;
  const unsigned kdst=lds0+LDS_K+wid*1024, vdst=lds0+LDS_V+wid*1024;
  #define DMA_K(t,slot) glds16(ksrc+(long)KT(t)*KVBLK*DM,(unsigned)__builtin_amdgcn_readfirstlane(kdst+(slot)))
  #define DMA_V(t,slot) glds16(vsrc+(long)KT(t)*KVBLK*DM,(unsigned)__builtin_amdgcn_readfirstlane(vdst+(slot)))
  const int vb0=(int)(lds0+LDS_V)+((lane>>4)&1)*32+(lane&3)*8+(4*hi+((lane&15)>>2))*64;
  const char*Kbase=shm+LDS_K; bf16x8 kf[8];
  const lds_cptr shm3=(lds_cptr)shm; const lds_cptr kp0=shm3+LDS_K+hi*1024+r32*16; const lds_cptr vp0=shm3+LDS_V+((lane>>4)&1)*32+(lane&3)*8+(4*hi+((lane&15)>>2))*64;
  const int NT=(q0+QB)/KVBLK;
  DMA_K(0,0);DMA_V(0,0);DMA_K(1,SLOTB);
  bf16x8 qr[4];
  #pragma unroll
  for(int d0=0;d0<4;++d0)qr[d0]=*reinterpret_cast<const bf16x8*>(&Qw[(long)r32*DM+d0*16+hi*8]);
  float mhat=0.f,l_reg=0.f;f32x16 o[2];o[0]=f32x16{};o[1]=f32x16{};const f32x16 zero16=f32x16{};
  const int qrel=wid*QBLK+r32;
  #define CMASK(P0,P1,t) do{ if((t)<4){cmask(P0,P1,(t),qrel,hi);} }while(0)
  bool resc=false;
  #define START(P0,P1) do{ const float rm=rowmax(P0,P1); resc=false; \
    { const float dl=rm; mhat=fadd_s(mhat,dl); \
      _Pragma("unroll") for(int r=0;r<16;++r){P0[r]=fsub_s(P0[r],dl);P1[r]=fsub_s(P1[r],dl);} \
      } \
    _Pragma("unroll") for(int r=0;r<16;++r)P0[r]=__builtin_amdgcn_exp2f(P0[r]); }while(0)
  #define RESC() do{ if(resc){ asm volatile("s_waitcnt lgkmcnt(0)":::"memory"); \
      _Pragma("unroll") for(int d_=0;d_<2;++d_) _Pragma("unroll") for(int r=0;r<16;++r)o[d_][r]*=wsf[crow(r,hi)]; } }while(0)
  f32x16 pA0,pA1,pB0,pB1;
  int sl_prev=0,sl_cur=0,sl_next=SLOTB;
  #define ROT() do{sl_prev=sl_cur;sl_cur=sl_next;sl_next=(sl_next==(NSLOT-1)*SLOTB)?0:sl_next+SLOTB;}while(0)
  DMA_K(2,2*SLOTB);
  WAIT_BAR(3);
  qkt(pA0,pA1,Kbase,qr,zero16,r32,hi);asm volatile("s_nop 15\n\ts_nop 7":"+v"(pA0),"+v"(pA1));CMASK(pA0,pA1,0);
  START(pA0,pA1);
  _Pragma("unroll") for(int r=0;r<16;++r)pA1[r]=__builtin_amdgcn_exp2f(pA1[r]);
  WAIT_BAR(0);
  DMA_K(3,0);DMA_V(1,SLOTB);
  ROT();
  kload8(kf,kp0+sl_cur);
  WAIT_BAR(2);
  s16x4 vlo[8],vhi[8]; u32x4 pw0,pw1,pw2,pw3;
  #define PKW(P,B) cvtpk_s(P[B],P[B+1])
  #define PAF(k) __builtin_bit_cast(bf16x8,pw##k)
  #define VFR(i) (bf16x8){vlo[i][0],vlo[i][1],vlo[i][2],vlo[i][3],vhi[i][0],vhi[i][1],vhi[i][2],vhi[i][3]}
  #define PIN(x) asm volatile("":"+v"(x))
  #define MX3(a,b,c) __builtin_fmaxf(__builtin_fmaxf((a),(b)),(c))
  #define GAPA(MF,A0,A1,A2,A3,W0,W1,PW) do{ MF; sacc+=A0; sacc+=A1; sacc+=A2; sacc+=A3; PIN(sacc); W0; W1; PIN(PW); SBAR(); }while(0)
  #define EX(v) __builtin_amdgcn_exp2f(v)
  #define GAPB(MF,X,B) do{ MF; X[B]=EX(X[B]); X[B+1]=EX(X[B+1]); X[B+2]=EX(X[B+2]); X[B+3]=EX(X[B+3]); PIN(X); SBAR(); }while(0)
  #define VRD(i) do{ vlo[i]=vtr(vp_+(((i)>>2)*4096+((i)&3)*1024)); vhi[i]=vtr(vp_+(((i)>>2)*4096+((i)&3)*1024+512)); }while(0)
  #define KRD(G,j) do{ if(G){ kload2(kf,kp0+sl_next,j); SBAR(); } }while(0)
    \
  #define STEP(C0,C1,P0,P1,t,GK,GV,GL) do{ SBAR(); \
    { const float nm_=(((t)<4)||((selbits>>(((t)-4)>>2))&1u))?-mhat:-INFINITY; _Pragma("unroll") for(int r_=0;r_<16;++r_){C0[r_]=nm_;C1[r_]=nm_;} PIN(C0); PIN(C1); SBAR(); } \
    const lds_cptr vp_=vp0+sl_prev; \
    VRD(0); SBAR(); float sacc=(P0[0]+P0[1]); \
    GAPA(C0=__builtin_amdgcn_mfma_f32_32x32x16_bf16(kf[0],qr[0],C0,0,0,0), P0[2],P0[3],P0[4],P0[5],     pw0[0]=PKW(P0,0), pw0[1]=PKW(P0,2), pw0); \
    VRD(4); SBAR(); GAPA(C1=__builtin_amdgcn_mfma_f32_32x32x16_bf16(kf[1],qr[0],C1,0,0,0), P0[6],P0[7],P0[8],P0[9],     pw0[2]=PKW(P0,4), pw0[3]=PKW(P0,6), pw0); \
    VRD(1); SBAR(); GAPA(C0=__builtin_amdgcn_mfma_f32_32x32x16_bf16(kf[2],qr[1],C0,0,0,0),   P0[10],P0[11],P0[12],P0[13], pw1[0]=PKW(P0,8), pw1[1]=PKW(P0,10), pw1); \
    VRD(5); SBAR(); GAPA(C1=__builtin_amdgcn_mfma_f32_32x32x16_bf16(kf[3],qr[1],C1,0,0,0),   P0[14],P0[15],P1[0],P1[1],   pw1[2]=PKW(P0,12),pw1[3]=PKW(P0,14), pw1); \
    VRD(2); SBAR(); GAPA(C0=__builtin_amdgcn_mfma_f32_32x32x16_bf16(kf[4],qr[2],C0,0,0,0),   P1[2],P1[3],P1[4],P1[5],     pw2[0]=PKW(P1,0), pw2[1]=PKW(P1,2), pw2); \
    VRD(6); SBAR(); GAPA(C1=__builtin_amdgcn_mfma_f32_32x32x16_bf16(kf[5],qr[2],C1,0,0,0),   P1[6],P1[7],P1[8],P1[9],     pw2[2]=PKW(P1,4), pw2[3]=PKW(P1,6), pw2); \
    VRD(3); SBAR(); GAPA(C0=__builtin_amdgcn_mfma_f32_32x32x16_bf16(kf[6],qr[3],C0,0,0,0),   P1[10],P1[11],P1[12],P1[13], pw3[0]=PKW(P1,8), pw3[1]=PKW(P1,10), pw3); \
    VRD(7); SBAR(); GAPA(C1=__builtin_amdgcn_mfma_f32_32x32x16_bf16(kf[7],qr[3],C1,0,0,0),   P1[14],P1[15],0.f,0.f,       pw3[2]=PKW(P1,12),pw3[3]=PKW(P1,14), pw3); \
    l_reg+=sacc; \
    if(GK){DMA_K((t)+3,sl_cur);} if(GV){DMA_V((t)+1,sl_next);} \
    CMASK(C0,C1,t); \
    { float a=MX3(C0[0],C0[1],C1[0]),b=MX3(C0[2],C0[3],C1[1]); a=MX3(a,C1[2],C1[3]); \
      _Pragma("unroll") for(int r=4;r<16;r+=4){a=MX3(a,C0[r],C0[r+1]);b=MX3(b,C0[r+2],C0[r+3]);a=MX3(a,C1[r],C1[r+1]);b=MX3(b,C1[r+2],C1[r+3]);} \
      float rm=__builtin_fmaxf(a,b); { auto rr=__builtin_amdgcn_permlane32_swap(__float_as_uint(rm),__float_as_uint(rm),false,false); rm=__builtin_fmaxf(__uint_as_float(rr[0]),__uint_as_float(rr[1])); } \
      resc=false; \
      if(__builtin_expect(__any(rm>(float)THRL),0)){ const float dl=__builtin_fmaxf(rm,0.f); mhat+=dl; \
        _Pragma("unroll") for(int r=0;r<16;++r){C0[r]-=dl;C1[r]-=dl;} \
        const float f=__builtin_amdgcn_exp2f(-dl); l_reg*=f; if(hi==0)wsf[r32]=f; resc=true; } } \
    SBAR(); \
    GAPB(o[0]=__builtin_amdgcn_mfma_f32_32x32x16_bf16(PAF(0),VFR(0),o[0],0,0,0), C0,0); \
    GAPB(o[1]=__builtin_amdgcn_mfma_f32_32x32x16_bf16(PAF(0),VFR(4),o[1],0,0,0), C0,4); \
    KRD(GL,0); GAPB(o[0]=__builtin_amdgcn_mfma_f32_32x32x16_bf16(PAF(1),VFR(1),o[0],0,0,0), C0,8); \
    KRD(GL,1); GAPB(o[1]=__builtin_amdgcn_mfma_f32_32x32x16_bf16(PAF(1),VFR(5),o[1],0,0,0), C0,12); \
    KRD(GL,2); GAPB(o[0]=__builtin_amdgcn_mfma_f32_32x32x16_bf16(PAF(2),VFR(2),o[0],0,0,0), C1,0); \
    KRD(GL,3); GAPB(o[1]=__builtin_amdgcn_mfma_f32_32x32x16_bf16(PAF(2),VFR(6),o[1],0,0,0), C1,4); \
    GAPB(o[0]=__builtin_amdgcn_mfma_f32_32x32x16_bf16(PAF(3),VFR(3),o[0],0,0,0), C1,8); \
    GAPB(o[1]=__builtin_amdgcn_mfma_f32_32x32x16_bf16(PAF(3),VFR(7),o[1],0,0,0), C1,12); \
    }while(0)
  int t=1;
  for(;t+5<NT;t+=2){
    STEP(pB0,pB1,pA0,pA1,t,true,true,true);     WAIT_BAR(2); RESC(); ROT();
    STEP(pA0,pA1,pB0,pB1,t+1,true,true,true);   WAIT_BAR(2); RESC(); ROT();
  }
  #define ENDW(tt) do{ if((tt)+3<NT){WAIT_BAR(2);} else if((tt)+2<NT){WAIT_BAR(1);} else {WAIT_BAR(0);} }while(0)
  for(;t+1<NT;t+=2){
    STEP(pB0,pB1,pA0,pA1,t,(t+3<NT),(t+1<NT),(t+1<NT));       ENDW(t);   RESC(); ROT();
    STEP(pA0,pA1,pB0,pB1,t+1,(t+4<NT),(t+2<NT),(t+2<NT));     ENDW(t+1); RESC(); ROT();
  }
  STEP(pB0,pB1,pA0,pA1,NT-1,false,false,false); RESC();
  { float sacc=pB0[0]+pB0[1]; _Pragma("unroll") for(int r=2;r<16;++r)sacc+=pB0[r]; _Pragma("unroll") for(int r=0;r<16;++r)sacc+=pB1[r]; l_reg+=sacc;
    pw0=(u32x4){PKW(pB0,0),PKW(pB0,2),PKW(pB0,4),PKW(pB0,6)};pw1=(u32x4){PKW(pB0,8),PKW(pB0,10),PKW(pB0,12),PKW(pB0,14)};pw2=(u32x4){PKW(pB1,0),PKW(pB1,2),PKW(pB1,4),PKW(pB1,6)};pw3=(u32x4){PKW(pB1,8),PKW(pB1,10),PKW(pB1,12),PKW(pB1,14)};
    SBAR(); pv(o,vb0+sl_cur,PAF(0),PAF(1),PAF(2),PAF(3)); }
  #undef PKW
  #undef PAF
  #undef VFR
  #undef PIN
  #undef MX3
  #undef GAPA
  #undef GAPB
  #undef EX
  #undef VRD
  #undef KRD
  #undef STEP
  #undef ENDW
  {auto rr=__builtin_amdgcn_permlane32_swap(__float_as_uint(l_reg),__float_as_uint(l_reg),false,false);l_reg=__uint_as_float(rr[0])+__uint_as_float(rr[1]);}
  if(hi==0)wsf[32+r32]=l_reg;asm volatile("s_waitcnt lgkmcnt(0)":::"memory");
  float rli[16];
  #pragma unroll
  for(int r=0;r<16;++r)rli[r]=__builtin_amdgcn_rcpf(wsf[32+crow(r,hi)]);
  bf16*Ow=O+(rowbase+q0+wid*QBLK)*OP+h*D;
  { bf16*stg=(bf16*)(shm+LDS_OST)+wid*2048;
    #pragma unroll
    for(int r=0;r<16;++r){const int orow=crow(r,hi);
      #pragma unroll
      for(int d0=0;d0<2;++d0)stg[orow*64+d0*32+r32]=__float2bfloat16(o[d0][r]*rli[r]);}
    asm volatile("s_waitcnt lgkmcnt(0)":::"memory");
    #pragma unroll
    for(int i=0;i<4;++i){const int row=i*8+(lane>>3),ch=lane&7; const u32x4 v=*(const u32x4*)(stg+row*64+ch*8); ATTN_STORE16(Ow+(long)row*OP+ch*8,v);} }
  asm volatile("s_waitcnt lgkmcnt(0)\n\ts_barrier":::"memory");
  #undef DMA_K
  #undef DMA_V
  #undef CMASK
  #undef START
  #undef RESC
  #undef ROT
}
constexpr int ATTN_LDS_BYTES=LDS_BYTES;
#undef KT
#undef SBAR
#undef WAIT_BAR
}
#define GAS __attribute__((address_space(1)))
#define LAS __attribute__((address_space(3)))
typedef unsigned short bf16;
typedef unsigned v4u __attribute__((ext_vector_type(4)));
typedef float f32x4 __attribute__((ext_vector_type(4)));
typedef short bf16x8 __attribute__((ext_vector_type(8)));
typedef GAS unsigned gu32;
typedef GAS unsigned long long gu64;
#define RLX_AGENT __ATOMIC_RELAXED, __HIP_MEMORY_SCOPE_AGENT
#define LDS_WAIT() asm volatile("s_waitcnt lgkmcnt(0)" ::: "memory")
#define VM_WAIT() asm volatile("s_waitcnt vmcnt(0)" ::: "memory")
__device__ __forceinline__ unsigned long long rt() { return __builtin_amdgcn_s_memrealtime(); }
__device__ __forceinline__ unsigned f2bf(float f) { unsigned u = __builtin_bit_cast(unsigned, f); return (u + 0x7fffu + ((u >> 16) & 1u)) >> 16; }
__device__ __forceinline__ unsigned pk2(float lo, float hi) { return f2bf(lo) | (f2bf(hi) << 16); }

#define XB_TMO      128
#define XB_XCNT(j)  (256  + 64 * (j))
#define XB_XSUB(j)  (1280 + 64 * (j))
#define XB_XGEN(j)  (2304 + 64 * (j))
#define XB_TOP      3328
#define XB_TOPGEN   3392
#define XCD_BAR_WORDS 3456
#define XB_SPIN_CAP (1u << 18)

__device__ __forceinline__ unsigned xb_ld(unsigned* p)              { return __hip_atomic_load(p, __ATOMIC_RELAXED, __HIP_MEMORY_SCOPE_AGENT); }
__device__ __forceinline__ unsigned xb_add(unsigned* p, unsigned v) { return __hip_atomic_fetch_add(p, v, __ATOMIC_RELAXED, __HIP_MEMORY_SCOPE_AGENT); }
__device__ __forceinline__ unsigned xb_xcc_id() { return (unsigned)__builtin_amdgcn_s_getreg((3 << 11) | 20) & 0xFu; }
#define XB_SPIN(cond, bar) do { unsigned _sp = 0; while (cond) { __builtin_amdgcn_s_sleep(1); \
    if ((++_sp & 255u) == 0u) { if (xb_ld(&(bar)[XB_TMO])) break; if (_sp > XB_SPIN_CAP) { atomicAdd(&(bar)[XB_TMO], 1u); break; } } } } while (0)

struct XcdBarrier {
    unsigned* bar; unsigned x;
    volatile LAS unsigned* st;
};

__device__ __forceinline__ XcdBarrier xcd_barrier_post(unsigned* bar, volatile LAS unsigned* st) {
    XcdBarrier b; b.bar = bar; b.x = xb_xcc_id(); b.st = st;
    if (threadIdx.x == 0) (void)xb_add(&bar[XB_XCNT(b.x)], 1u);
    return b;
}
__device__ __forceinline__ void xcd_barrier_complete(unsigned* bar, unsigned x, unsigned& nloc, unsigned& nx) {
    const unsigned G = gridDim.x * gridDim.y * gridDim.z;
    unsigned sum, cnt, mine, sp = 0u;
    for (;;) {
        sum = 0u; cnt = 0u; mine = 0u;
#pragma unroll
        for (unsigned j = 0; j < 16; ++j) { const unsigned c = xb_ld(&bar[XB_XCNT(j)]); sum += c; cnt += (c > 0u) ? 1u : 0u; mine = (j == x) ? c : mine; }
        if (sum == G) break;
        __builtin_amdgcn_s_sleep(1);
        if ((++sp & 255u) == 0u) { if (xb_ld(&bar[XB_TMO])) break; if (sp > XB_SPIN_CAP) { atomicAdd(&bar[XB_TMO], 1u); break; } }
    }
    nloc = mine > 0u ? mine : 1u; nx = cnt > 0u ? cnt : 1u;
}

__device__ __forceinline__ void xcd_barrier(const XcdBarrier& b) {
    asm volatile("s_waitcnt vmcnt(0)" ::: "memory");
    __syncthreads();
    if (threadIdx.x == 0) {
        unsigned* bar = b.bar;
        __builtin_amdgcn_s_waitcnt(0);
        unsigned nloc = b.st[0], nx = b.st[1];
        if (nloc == 0u) { xcd_barrier_complete(bar, b.x, nloc, nx); b.st[0] = nloc; b.st[1] = nx; }
        const unsigned old = xb_add(&bar[XB_XSUB(b.x)], 1u);
        const unsigned gen = old / nloc;
        if (old + 1u == (gen + 1u) * nloc) {
            __builtin_amdgcn_fence(__ATOMIC_RELEASE, "agent");
            asm volatile("s_waitcnt vmcnt(0)" ::: "memory");
            const unsigned og = xb_add(&bar[XB_TOP], 1u);
            const unsigned tg = og / nx;
            if (og + 1u == (tg + 1u) * nx) xb_add(&bar[XB_TOPGEN], 1u);
            else XB_SPIN(xb_ld(&bar[XB_TOPGEN]) == tg, bar);
            __builtin_amdgcn_fence(__ATOMIC_ACQUIRE, "agent");
            xb_add(&bar[XB_XGEN(b.x)], 1u);
            asm volatile("s_waitcnt vmcnt(0)" ::: "memory");
        } else {
            XB_SPIN(xb_ld(&bar[XB_XGEN(b.x)]) == gen, bar);
            __builtin_amdgcn_fence(__ATOMIC_ACQUIRE, "agent");
            asm volatile("s_waitcnt vmcnt(0)" ::: "memory");
        }
    }
    __syncthreads();
}

using namespace mdl;
constexpr int NWAVES = 8;
#ifndef SSM_NAIVE
#define SSM_NAIVE 0
#endif
#ifndef ATTN_NAIVE
#define ATTN_NAIVE 0
#endif
#ifndef DUPM
#define DUPM 0
#endif
#define NREP(t) ((((DUPM) >> (t)) & 1) ? 2 : 1)
#ifndef MK_ONE_LAUNCH
#define MK_ONE_LAUNCH 1
#endif
constexpr int N_PHASES = 14;
constexpr size_t MiB = 1u << 20;
constexpr size_t WS_CTL = 0, CTL_ZERO_BYTES = 1 * MiB;
constexpr size_t WS_ROPE = 1 * MiB;
constexpr size_t WS_KMP = 1 * MiB + 512 * 1024;
constexpr size_t WS_SSQ = 2 * MiB;
constexpr size_t WS_W = 8 * MiB, W_LAYER = 24 * MiB;
constexpr size_t WO_IN = 0, WO_OUT = 5 * MiB, WO_GU = 7 * MiB, WO_DN = 18 * MiB, WO_GLU = 23 * MiB + 512 * 1024, WO_PW2 = 23 * MiB + 768 * 1024;
constexpr size_t WS_HB = 64 * MiB;
constexpr size_t WS_QB = 128 * MiB, WS_KB = 160 * MiB, WS_VB = 192 * MiB, WS_QF = 224 * MiB, WS_US = 288 * MiB, WS_UC = 304 * MiB, WS_Z = 320 * MiB, WS_YC = 336 * MiB, WS_MIX = 352 * MiB;
constexpr size_t WS_ACT = 128 * MiB;
constexpr size_t WS_END = 432 * MiB;
static_assert(WS_ACT + (size_t)M * D_FF * 2 <= WS_UC + 16 * MiB && WS_MIX + (size_t)M * DM * 2 <= WS_END, "d_ws map");
constexpr int CW_TMO = 0, CW_CODE = 1, CW_BAR = 4096;
constexpr int RING_OFF = 0, RING_BYTES = 131072;
constexpr int LDSCTL_OFF = RING_BYTES, MISC_OFF = LDSCTL_OFF + 320;
constexpr int LDS_BYTES = 147456;

struct Frame {
    LAS unsigned char* lds;
    volatile LAS unsigned* MISC;
    gu32* ctl;
    int tid, lane, wave;
    int vcu, G;
    unsigned char* ws;
};
using pg8::shx;
__device__ __forceinline__ float wave_sum(float v, int ln) {
#pragma unroll
    for (int o = 1; o < 64; o <<= 1) v += shx(v, o, ln);
    return v;
}
__device__ __forceinline__ float wave_max(float v, int ln) {
#pragma unroll
    for (int o = 1; o < 64; o <<= 1) v = fmaxf(v, shx(v, o, ln));
    return v;
}
__device__ __forceinline__ float bf2f(bf16 v) { return __uint_as_float((unsigned)v << 16); }

__device__ __forceinline__ void p0_transpose_item(const float* W, int K, int Nsrc, bf16* WT, int k0, int nsrc0, int nout0, const float* ks, LAS float* scr, int lane) {
    float tv[32];
#pragma unroll
    for (int i = 0; i < 32; ++i) { const int kk = 2 * i + (lane >> 5); tv[i] = W[(size_t)(k0 + kk) * Nsrc + nsrc0 + (lane & 31)]; }
#pragma unroll
    for (int i = 0; i < 32; ++i) { const int kk = 2 * i + (lane >> 5); float v = tv[i]; if (ks) v *= ks[k0 + kk]; scr[kk * 33 + (lane & 31)] = v; }
    LDS_WAIT(); asm volatile("" ::: "memory");
    const int c = lane & 7;
#pragma unroll
    for (int j = 0; j < 4; ++j) { const int n = (lane >> 3) + 8 * j; const LAS float* s = scr + (8 * c) * 33 + n;
        v4u o; o.x = pk2(s[0 * 33], s[1 * 33]); o.y = pk2(s[2 * 33], s[3 * 33]); o.z = pk2(s[4 * 33], s[5 * 33]); o.w = pk2(s[6 * 33], s[7 * 33]);
        *(GAS v4u*)(WT + (size_t)(nout0 + n) * K + k0 + 8 * c) = o; }
    LDS_WAIT(); asm volatile("" ::: "memory");
}
struct Inputs { const float* p[27]; };
__device__ __forceinline__ void ssm_build_item(Frame& F, const Inputs& I, int lg);
__device__ __forceinline__ void p0_prologue(Frame& F, const Inputs& I) {
    LAS float* scr = (LAS float*)(F.lds + RING_OFF + F.wave * 16384);
    const int gw = F.vcu * NWAVES + F.wave, NGW = F.G * NWAVES;
    const int nbld = (F.G >= 64) ? DEPTH * NGRP : 0;
    for (int it = F.vcu; it < DEPTH * NGRP; it += F.G) if (nbld == 0 || F.vcu < nbld) ssm_build_item(F, I, it);
    const int tw0 = nbld ? (F.vcu - nbld) * NWAVES + F.wave : gw, tnw = nbld ? (F.G - nbld) * NWAVES : NGW;
    constexpr int I_IN = 16 * 72, I_OUT = 16 * 32, I_GU = 16 * 176, I_DN = 44 * 32, I_SM = 4 * 8;
    constexpr int I_LAYER = I_IN + I_OUT + I_GU + I_DN + 2 * I_SM;
    if (tw0 >= 0) for (int it = tw0; it < DEPTH * I_LAYER; it += tnw) {
        const int l = it / I_LAYER; int r = it % I_LAYER;
        unsigned char* wl = F.ws + WS_W + (size_t)l * W_LAYER;
        if (r < I_IN) { const int kb = r / 72, nb = r % 72, n0 = nb * 32; int src = n0;
            if (n0 >= 1792) { const int q = n0 - 1792, j = q >> 8, rr = q & 255; src = ((rr >> 7) ? 2048 : 1792) + 128 * j + (rr & 127); }
            p0_transpose_item(I.p[2] + (size_t)l * DM * D_IN, DM, D_IN, (bf16*)(wl + WO_IN), kb * 64, src, n0, I.p[1] + l * DM, scr, F.lane); continue; }
        r -= I_IN;
        if (r < I_OUT) { const int kb = r / 32, nb = r % 32, k0 = kb * 64;
            const float* ks = k0 < 512 ? I.p[19] + l * 512 - 0 : (k0 < 768 ? I.p[20] + l * 256 - 512 : I.p[21] + l * 256 - 768);
            p0_transpose_item(I.p[22] + (size_t)l * DM * DM, DM, DM, (bf16*)(wl + WO_OUT), k0, nb * 32, nb * 32, ks, scr, F.lane); continue; }
        r -= I_OUT;
        if (r < I_GU) { const int kb = r / 176, nb = r % 176, n0 = nb * 32; const int j = n0 >> 8, rr = n0 & 255; const int src = ((rr >> 7) ? D_FF : 0) + 128 * j + (rr & 127);
            p0_transpose_item(I.p[24] + (size_t)l * DM * D_GU, DM, D_GU, (bf16*)(wl + WO_GU), kb * 64, src, n0, I.p[23] + l * DM, scr, F.lane); continue; }
        r -= I_GU;
        if (r < I_DN) { const int kb = r / 32, nb = r % 32;
            p0_transpose_item(I.p[25] + (size_t)l * D_FF * DM, D_FF, DM, (bf16*)(wl + WO_DN), kb * 64, nb * 32, nb * 32, nullptr, scr, F.lane); continue; }
        r -= I_DN;
        if (r < I_SM) { const int kb = r / 8, nb = r % 8;
            p0_transpose_item(I.p[11] + (size_t)l * 65536, 256, 256, (bf16*)(wl + WO_GLU), kb * 64, nb * 32, nb * 32, nullptr, scr, F.lane); continue; }
        r -= I_SM;
        { const int kb = r / 8, nb = r % 8;
            p0_transpose_item(I.p[17] + (size_t)l * 65536, 256, 256, (bf16*)(wl + WO_PW2), kb * 64, nb * 32, nb * 32, nullptr, scr, F.lane); }
    }
    const float* x = I.p[0]; bf16* hb = (bf16*)(F.ws + WS_HB); float* ssq = (float*)(F.ws + WS_SSQ);
    for (int m0 = gw * 4; m0 < M; m0 += NGW * 4) {
        f32x4 v[4][4];
#pragma unroll
        for (int r = 0; r < 4; ++r) { const GAS f32x4* xr = (const GAS f32x4*)(x + (size_t)(m0 + r) * DM) + F.lane;
#pragma unroll
            for (int j = 0; j < 4; ++j) v[r][j] = xr[64 * j]; }
#pragma unroll
        for (int r = 0; r < 4; ++r) { float s = 0.f;
#pragma unroll
            for (int j = 0; j < 4; ++j) s += (v[r][j].x * v[r][j].x + v[r][j].y * v[r][j].y) + (v[r][j].z * v[r][j].z + v[r][j].w * v[r][j].w);
            s = wave_sum(s, F.lane);
            GAS unsigned long long* o8 = (GAS unsigned long long*)(hb + (size_t)(m0 + r) * DM) + F.lane;
#pragma unroll
            for (int j = 0; j < 4; ++j) o8[64 * j] = (unsigned long long)pk2(v[r][j].x, v[r][j].y) | ((unsigned long long)pk2(v[r][j].z, v[r][j].w) << 32);
            if (F.lane < 16) ssq[(size_t)(m0 + r) * 16 + F.lane] = F.lane == 0 ? s : 0.f; }
    }
    float* rope = (float*)(F.ws + WS_ROPE);
    for (int i = gw * 64 + F.lane; i < SEQ * 8; i += NGW * 64) { const int pos = i >> 3, f = i & 7;
        const float inv = powf(500000.0f, -(float)(2 * f) / 16.0f); const float ang = (float)pos * inv;
        rope[2 * i] = cosf(ang); rope[2 * i + 1] = sinf(ang); }
}

__device__ __forceinline__ void attn_naive_unit(Frame& F, int b, int h, int qb) {
    LAS float* km = (LAS float*)(F.lds);
    LAS unsigned* selm = (LAS unsigned*)(F.lds + 4096);
    LAS float* sc = (LAS float*)(F.lds + 8192) + F.wave * 1024;
    LAS float* qs = (LAS float*)(F.lds + 8192 + 8 * 4096) + F.wave * 64;
    const float* kmp = (const float*)(F.ws + WS_KMP); const float* Qf = (const float*)(F.ws + WS_QF);
    const bf16* Qb = (const bf16*)(F.ws + WS_QB); const bf16* Kb = (const bf16*)(F.ws + WS_KB); const bf16* Vb = (const bf16*)(F.ws + WS_VB); bf16* mix = (bf16*)(F.ws + WS_MIX);
    __syncthreads();
    for (int i = F.tid; i < 16 * 64; i += 512) { const int n = i >> 6, d = i & 63; float v = 0.f;
        if (n < qb) { const size_t idx = ((size_t)(b * NBLK + n) * 512) + h * 64 + d; v = (kmp[idx] + kmp[(size_t)BATCH * NBLK * 512 + idx]) * (1.0f / 256.0f); }
        km[i] = v; }
    __syncthreads();
    if (F.tid < 256) {
        const float* q = Qf + ((size_t)(b * SEQ + qb * 256 + F.tid)) * 512 + h * 64;
        float g[15];
#pragma unroll
        for (int n = 0; n < 15; ++n) g[n] = 0.f;
        for (int d4 = 0; d4 < 16; ++d4) { const f32x4 qv = *(const f32x4*)(q + 4 * d4);
#pragma unroll
            for (int n = 0; n < 15; ++n) { const LAS float* kk = km + n * 64 + 4 * d4; g[n] += (qv.x * kk[0] + qv.y * kk[1]) + (qv.z * kk[2] + qv.w * kk[3]); } }
        unsigned mask = 0u; const int topk = qb < 3 ? qb : 3;
        for (int k = 0; k < topk; ++k) { float best = -INFINITY; int bi = 0;
#pragma unroll
            for (int n = 0; n < 15; ++n) { const bool ok = n < qb && !((mask >> n) & 1u) && g[n] > best; best = ok ? g[n] : best; bi = ok ? n : bi; }
            mask |= 1u << bi; }
        selm[F.tid] = mask;
    }
    __syncthreads();
    for (int i = 0; i < 32; ++i) {
        const int t = F.wave * 32 + i, qpos = qb * 256 + t; const size_t row = (size_t)b * SEQ + qpos;
        const unsigned mask = selm[t] | (1u << qb);
        qs[F.lane] = bf2f(Qb[row * 512 + h * 64 + F.lane]);
        LDS_WAIT();
        int cnt = 0; float mx = -INFINITY;
        for (int n = 0; n <= qb; ++n) { if (!((mask >> n) & 1u)) continue;
            for (int kk = 0; kk < 4; ++kk) { const int key0 = n * 256 + kk * 64; if (key0 > qpos) break; const int key = key0 + F.lane;
                const v4u* kr = (const v4u*)(Kb + ((size_t)b * SEQ + key) * 512 + h * 64); float s = 0.f;
#pragma unroll
                for (int c = 0; c < 8; ++c) { const v4u w = kr[c]; const LAS float* qq = qs + 8 * c;
                    s += qq[0] * __uint_as_float(w.x << 16) + qq[1] * __uint_as_float(w.x & 0xffff0000u) + qq[2] * __uint_as_float(w.y << 16) + qq[3] * __uint_as_float(w.y & 0xffff0000u)
                       + qq[4] * __uint_as_float(w.z << 16) + qq[5] * __uint_as_float(w.z & 0xffff0000u) + qq[6] * __uint_as_float(w.w << 16) + qq[7] * __uint_as_float(w.w & 0xffff0000u); }
                if (key > qpos) s = -INFINITY;
                sc[cnt * 64 + F.lane] = s; mx = fmaxf(mx, s); ++cnt; } }
        mx = wave_max(mx, F.lane); float l = 0.f;
        for (int c = 0; c < cnt; ++c) { const float p = exp2f(sc[c * 64 + F.lane] - mx); sc[c * 64 + F.lane] = p; l += p; }
        l = wave_sum(l, F.lane); LDS_WAIT();
        float o = 0.f; int c = 0;
        for (int n = 0; n <= qb; ++n) { if (!((mask >> n) & 1u)) continue;
            for (int kk = 0; kk < 4; ++kk) { const int key0 = n * 256 + kk * 64; if (key0 > qpos) break;
                const bf16* vr = Vb + ((size_t)b * SEQ + key0) * 512 + h * 64 + F.lane;
#pragma unroll 8
                for (int j = 0; j < 64; ++j) o += sc[c * 64 + j] * bf2f(vr[(size_t)j * 512]);
                ++c; } }
        mix[row * DM + h * 64 + F.lane] = (bf16)f2bf(o / l);
        LDS_WAIT();
    }
}

__device__ __forceinline__ float gelu_tanh(float x) { const float u = 0.7978845608028654f * (x + 0.044715f * x * x * x); return 0.5f * x * (1.0f + tanhf(u)); }
__device__ __forceinline__ void ssm_naive_unit(Frame& F, const Inputs& I, int l, int b, int g) {
    const int p = F.lane, w = F.wave;
    LAS float* S = (LAS float*)(F.lds + LDSCTL_OFF + 1024);
    LAS unsigned char* ubuf = F.lds + w * 16384;
    const size_t gp = ((size_t)l * NGRP + g) * NST + p;
    const float dt = expf(I.p[5][l * NGRP + g]); const float lr = I.p[3][gp], li = I.p[4][gp];
    const float mag = expf(lr * dt); const float ar = mag * cosf(li * dt), ai = mag * sinf(li * dt);
    const float nr = ar - 1.0f, den = lr * lr + li * li; const float fr = (nr * lr + ai * li) / den, fi = (ai * lr - nr * li) / den;
    float bbr[16], bbi[16], cr[16], ci[16], dsk[16];
#pragma unroll
    for (int c = 0; c < 16; ++c) { const float br = I.p[6][gp * 16 + c], bi = I.p[7][gp * 16 + c]; bbr[c] = fr * br - fi * bi; bbi[c] = fr * bi + fi * br;
        const size_t ci_ = (((size_t)l * NGRP + g) * GCH + c) * NST + p; cr[c] = I.p[8][ci_]; ci[c] = I.p[9][ci_]; dsk[c] = I.p[10][(l * NGRP + g) * GCH + c]; }
    const bf16* Us = (const bf16*)(F.ws + WS_US); bf16* Z = (bf16*)(F.ws + WS_Z);
    const size_t row0 = (size_t)b * SEQ + w * 512;
    __syncthreads();
#pragma unroll 4
    for (int k = 0; k < 16; ++k) { const int j = p + 64 * k; *(LAS v4u*)(ubuf + j * 16) = *(const v4u*)(Us + (row0 + (j >> 1)) * 256 + g * 16 + (j & 1) * 8); }
    LDS_WAIT();
    float hr = 0.f, hi = 0.f;
    for (int t = 0; t < 512; ++t) {
        const LAS v4u* ur = (const LAS v4u*)(ubuf + t * 32); const v4u u0 = ur[0], u1 = ur[1];
        const float uu[16] = {__uint_as_float(u0.x << 16), __uint_as_float(u0.x & 0xffff0000u), __uint_as_float(u0.y << 16), __uint_as_float(u0.y & 0xffff0000u), __uint_as_float(u0.z << 16), __uint_as_float(u0.z & 0xffff0000u), __uint_as_float(u0.w << 16), __uint_as_float(u0.w & 0xffff0000u),
                              __uint_as_float(u1.x << 16), __uint_as_float(u1.x & 0xffff0000u), __uint_as_float(u1.y << 16), __uint_as_float(u1.y & 0xffff0000u), __uint_as_float(u1.z << 16), __uint_as_float(u1.z & 0xffff0000u), __uint_as_float(u1.w << 16), __uint_as_float(u1.w & 0xffff0000u)};
        float xr = 0.f, xi = 0.f;
#pragma unroll
        for (int c = 0; c < 16; ++c) { xr += bbr[c] * uu[c]; xi += bbi[c] * uu[c]; }
        const float nr2 = ar * hr - ai * hi + xr, ni2 = ar * hi + ai * hr + xi; hr = nr2; hi = ni2;
    }
    __syncthreads();
    S[(w * 64 + p) * 2] = hr; S[(w * 64 + p) * 2 + 1] = hi;
    __syncthreads();
    float pr = ar, pi = ai;
#pragma unroll
    for (int k = 0; k < 9; ++k) { const float t0 = pr * pr - pi * pi, t1 = 2.0f * pr * pi; pr = t0; pi = t1; }
    hr = 0.f; hi = 0.f;
    for (int j = 0; j < w; ++j) { const float sr = S[(j * 64 + p) * 2], si = S[(j * 64 + p) * 2 + 1]; const float t0 = pr * hr - pi * hi + sr, t1 = pr * hi + pi * hr + si; hr = t0; hi = t1; }
    for (int t = 0; t < 512; ++t) {
        const LAS v4u* ur = (const LAS v4u*)(ubuf + t * 32); const v4u u0 = ur[0], u1 = ur[1];
        const float uu[16] = {__uint_as_float(u0.x << 16), __uint_as_float(u0.x & 0xffff0000u), __uint_as_float(u0.y << 16), __uint_as_float(u0.y & 0xffff0000u), __uint_as_float(u0.z << 16), __uint_as_float(u0.z & 0xffff0000u), __uint_as_float(u0.w << 16), __uint_as_float(u0.w & 0xffff0000u),
                              __uint_as_float(u1.x << 16), __uint_as_float(u1.x & 0xffff0000u), __uint_as_float(u1.y << 16), __uint_as_float(u1.y & 0xffff0000u), __uint_as_float(u1.z << 16), __uint_as_float(u1.z & 0xffff0000u), __uint_as_float(u1.w << 16), __uint_as_float(u1.w & 0xffff0000u)};
        float xr = 0.f, xi = 0.f;
#pragma unroll
        for (int c = 0; c < 16; ++c) { xr += bbr[c] * uu[c]; xi += bbi[c] * uu[c]; }
        const float nr2 = ar * hr - ai * hi + xr, ni2 = ar * hi + ai * hr + xi; hr = nr2; hi = ni2;
        float v[16];
#pragma unroll
        for (int c = 0; c < 16; ++c) v[c] = cr[c] * hr - ci[c] * hi;
        float v8[8], v4[4], v2[2], v1;
        { const bool up = (p & 32) != 0;
#pragma unroll
          for (int c = 0; c < 8; ++c) { const float keep = up ? v[c + 8] : v[c], send = up ? v[c] : v[c + 8]; v8[c] = keep + shx(send, 32, p); } }
        { const bool up = (p & 16) != 0;
#pragma unroll
          for (int c = 0; c < 4; ++c) { const float keep = up ? v8[c + 4] : v8[c], send = up ? v8[c] : v8[c + 4]; v4[c] = keep + shx(send, 16, p); } }
        { const bool up = (p & 8) != 0;
#pragma unroll
          for (int c = 0; c < 2; ++c) { const float keep = up ? v4[c + 2] : v4[c], send = up ? v4[c] : v4[c + 2]; v2[c] = keep + shx(send, 8, p); } }
        { const bool up = (p & 4) != 0; const float keep = up ? v2[1] : v2[0], send = up ? v2[0] : v2[1]; v1 = keep + shx(send, 4, p); }
        v1 += shx(v1, 2, p); v1 += shx(v1, 1, p);
        const int c = ((p >> 5) & 1) * 8 + ((p >> 4) & 1) * 4 + ((p >> 3) & 1) * 2 + ((p >> 2) & 1);
        float uc = uu[0], dc = dsk[0];
#pragma unroll
        for (int k = 1; k < 16; ++k) { uc = (c == k) ? uu[k] : uc; dc = (c == k) ? dsk[k] : dc; }
        const float y = v1 + dc * uc;
        if ((p & 3) == 0) Z[(row0 + t) * 256 + g * 16 + c] = (bf16)f2bf(gelu_tanh(y));
    }
}


constexpr size_t WS_SSMF = 424 * MiB;
constexpr int SSM_NFR = 200, SSM_TOFF = 0, SSM_POFF = 72, SSM_QOFF = 136;
__host__ __device__ constexpr int ssm_toff(int mt) { return (mt & 1) ? ((mt >> 1) + 1) * ((mt >> 1) + 1) : (mt >> 1) * ((mt >> 1) + 1); }
__device__ __forceinline__ void cmul(float ar, float ai, float br, float bi, float& cr, float& ci) { cr = ar * br - ai * bi; ci = ar * bi + ai * br; }

__device__ __forceinline__ void ssm_build_item(Frame& F, const Inputs& I, int lg) {
    LAS float* apow = (LAS float*)(F.lds);
    LAS float* bbar = apow + 64 * 17 * 2;
    LAS float* cc = bbar + 64 * 16 * 2;
    LAS float* Kt = cc + 16 * 64 * 2;
    const int tid = F.tid;
    __syncthreads();
    if (tid < 64) {
        const int p = tid; const size_t gp = (size_t)lg * NST + p;
        const float dt = expf(I.p[5][lg]); const float lr = I.p[3][gp], li = I.p[4][gp];
        const float mag = expf(lr * dt); const float ar = mag * cosf(li * dt), ai = mag * sinf(li * dt);
        const float nr = ar - 1.0f, den = lr * lr + li * li; const float fr = (nr * lr + ai * li) / den, fi = (ai * lr - nr * li) / den;
        float pr = 1.f, pi = 0.f;
        for (int t = 0; t <= 16; ++t) { apow[(p * 17 + t) * 2] = pr; apow[(p * 17 + t) * 2 + 1] = pi; float nr2, ni2; cmul(pr, pi, ar, ai, nr2, ni2); pr = nr2; pi = ni2; }
        for (int c = 0; c < 16; ++c) { const float br = I.p[6][gp * 16 + c], bi = I.p[7][gp * 16 + c]; bbar[(p * 16 + c) * 2] = fr * br - fi * bi; bbar[(p * 16 + c) * 2 + 1] = fr * bi + fi * br; }
    }
    for (int i = tid; i < 1024; i += 512) { cc[2 * i] = I.p[8][(size_t)lg * 1024 + i]; cc[2 * i + 1] = I.p[9][(size_t)lg * 1024 + i]; }
    __syncthreads();
    for (int e = tid; e < 4096; e += 512) { const int tau = e >> 8, c = (e >> 4) & 15, c2 = e & 15; float s = 0.f;
        for (int p = 0; p < 64; ++p) { float tr, ti; cmul(apow[(p * 17 + tau) * 2], apow[(p * 17 + tau) * 2 + 1], bbar[(p * 16 + c2) * 2], bbar[(p * 16 + c2) * 2 + 1], tr, ti);
            s += cc[(c * 64 + p) * 2] * tr - cc[(c * 64 + p) * 2 + 1] * ti; }
        if (tau == 0 && c == c2) s += I.p[10][lg * 16 + c];
        Kt[e] = s; }
    __syncthreads();
    bf16* fb = (bf16*)(F.ws + WS_SSMF) + (size_t)lg * SSM_NFR * 512;
    for (int it = tid; it < SSM_NFR * 64; it += 512) {
        const int fi_ = it >> 6, l = it & 63, q4 = l >> 4, i16 = l & 15; float v[8];
        if (fi_ < SSM_POFF) {
            int mt = 0;
#pragma unroll
            for (int m = 1; m < 16; ++m) if (fi_ >= ssm_toff(m)) mt = m;
            const int kt = fi_ - ssm_toff(mt), s2 = 2 * kt + (q4 >> 1), c2b = 8 * (q4 & 1);
#pragma unroll
            for (int j = 0; j < 8; ++j) v[j] = (s2 <= mt) ? Kt[((mt - s2) * 16 + i16) * 16 + c2b + j] : 0.f;
        } else if (fi_ < SSM_QOFF) {
            const int f2 = fi_ - SSM_POFF, mp = f2 >> 3, kt = f2 & 7, p = 8 * mp + (i16 >> 1), ri = i16 & 1, s2 = 2 * kt + (q4 >> 1), c2b = 8 * (q4 & 1);
            const float pr = apow[(p * 17 + 15 - s2) * 2], pi = apow[(p * 17 + 15 - s2) * 2 + 1];
#pragma unroll
            for (int j = 0; j < 8; ++j) { float wr_, wi_; cmul(pr, pi, bbar[(p * 16 + c2b + j) * 2], bbar[(p * 16 + c2b + j) * 2 + 1], wr_, wi_); v[j] = ri ? wi_ : wr_; }
        } else {
            const int f2 = fi_ - SSM_QOFF, mt = f2 >> 2, kq = f2 & 3;
#pragma unroll
            for (int j = 0; j < 8; ++j) { const int kk = 32 * kq + 8 * q4 + j, p = kk >> 1, ri = kk & 1; float wr_, wi_;
                cmul(cc[(i16 * 64 + p) * 2], cc[(i16 * 64 + p) * 2 + 1], apow[(p * 17 + mt + 1) * 2], apow[(p * 17 + mt + 1) * 2 + 1], wr_, wi_); v[j] = ri ? -wi_ : wr_; }
        }
        v4u o; o.x = pk2(v[0], v[1]); o.y = pk2(v[2], v[3]); o.z = pk2(v[4], v[5]); o.w = pk2(v[6], v[7]);
        *(GAS v4u*)(fb + (size_t)it * 8) = o;
    }
    __syncthreads();
}

template <int CTRL> __device__ __forceinline__ float dpp_shr0(float v) {
    return __builtin_bit_cast(float, __builtin_amdgcn_update_dpp(0, __builtin_bit_cast(int, v), CTRL, 0xf, 0xf, true)); }
__device__ __forceinline__ float row_last(float v) {
    return __builtin_bit_cast(float, __builtin_amdgcn_ds_swizzle(__builtin_bit_cast(int, v), 0x1F0)); }
__device__ __forceinline__ float gelu_fast(float x) { const float u = 0.7978845608028654f * (x + 0.044715f * x * x * x); const float e = __expf(2.0f * u); return x * (1.0f - 1.0f / (1.0f + e)); }

constexpr int SSM_UB = 8704, SSM_HB = 4352;
__device__ __forceinline__ void ssm_mfma_unit(Frame& F, const Inputs& I, unsigned char* wsu, int l, int b, int g) {
    typedef short bf16x8 __attribute__((ext_vector_type(8)));
    int tid = threadIdx.x; asm volatile("" : "+v"(tid));
    const int lane = tid & 63, w = __builtin_amdgcn_readfirstlane(tid >> 6), q4 = lane >> 4, n = lane & 15;
    const int lg = l * NGRP + g;
    LAS unsigned char* ubuf = F.lds; LAS unsigned char* hbuf = F.lds + 2 * SSM_UB;
    const bf16x8* fb = (const bf16x8*)(wsu + WS_SSMF) + (size_t)lg * SSM_NFR * 64 + lane;
    const int mtA = w, mtB = 15 - w, nA = (mtA >> 1) + 1, nB = (mtB >> 1) + 1;
    bf16x8 Pf[8], TA[4], TB[8], QA[4], QB[4];
#pragma unroll
    for (int k = 0; k < 8; ++k) Pf[k] = fb[(SSM_POFF + w * 8 + k) * 64];
#pragma unroll
    for (int k = 0; k < 4; ++k) TA[k] = fb[(ssm_toff(mtA) + (k < nA ? k : 0)) * 64];
#pragma unroll
    for (int k = 0; k < 8; ++k) TB[k] = fb[(ssm_toff(mtB) + (k < nB ? k : 0)) * 64];
#pragma unroll
    for (int k = 0; k < 4; ++k) { QA[k] = fb[(SSM_QOFF + mtA * 4 + k) * 64]; QB[k] = fb[(SSM_QOFF + mtB * 4 + k) * 64]; }
    float l1r[2], l1i[2], l2r[2], l2i[2], l4r[2], l4i[2], l8r[2], l8i[2], lnr[2], lni[2], l16r[2], l16i[2];
    { const float dt = expf(I.p[5][lg]);
#pragma unroll
      for (int s = 0; s < 2; ++s) { const size_t gp = (size_t)lg * NST + 8 * w + 2 * q4 + s; const float lr = I.p[3][gp], li = I.p[4][gp];
        const float mag = expf(lr * dt); float ar = mag * cosf(li * dt), ai = mag * sinf(li * dt), tr, ti;
#pragma unroll
        for (int k = 0; k < 4; ++k) { cmul(ar, ai, ar, ai, tr, ti); ar = tr; ai = ti; }
        l1r[s] = ar; l1i[s] = ai; cmul(ar, ai, ar, ai, l2r[s], l2i[s]); cmul(l2r[s], l2i[s], l2r[s], l2i[s], l4r[s], l4i[s]); cmul(l4r[s], l4i[s], l4r[s], l4i[s], l8r[s], l8i[s]);
        cmul(l8r[s], l8i[s], l8r[s], l8i[s], l16r[s], l16i[s]);
        float pr = 1.f, pi = 0.f;
        if (n & 1) { cmul(pr, pi, l1r[s], l1i[s], tr, ti); pr = tr; pi = ti; }
        if (n & 2) { cmul(pr, pi, l2r[s], l2i[s], tr, ti); pr = tr; pi = ti; }
        if (n & 4) { cmul(pr, pi, l4r[s], l4i[s], tr, ti); pr = tr; pi = ti; }
        if (n & 8) { cmul(pr, pi, l8r[s], l8i[s], tr, ti); pr = tr; pi = ti; }
        lnr[s] = pr; lni[s] = pi; } }
    float h0r[2] = {0.f, 0.f}, h0i[2] = {0.f, 0.f};
    const bf16* Us = (const bf16*)(wsu + WS_US); bf16* Z = (bf16*)(wsu + WS_Z);
    const size_t rowb = (size_t)b * SEQ;
    const int ctok = tid >> 1, chalf = tid & 1; const int cdst = (ctok >> 4) * 544 + (ctok & 15) * 32 + chalf * 16;
    const bf16* csrc = Us + (rowb + ctok) * 256 + g * 16 + chalf * 8;
    __syncthreads();
    { const v4u c0 = *(const v4u*)csrc; *(LAS v4u*)(ubuf + cdst) = c0; }
    v4u cnext = *(const v4u*)(csrc + (size_t)256 * 256);
    __syncthreads();
    const int urd = n * 544 + (q4 >> 1) * 32 + (q4 & 1) * 16;
    const int hwr = n * 272 + (16 * w + 4 * q4) * 2, hrd = n * 272 + q4 * 16;
    for (int k = 0; k < 16; ++k) {
        LAS unsigned char* ub = ubuf + (k & 1) * SSM_UB; LAS unsigned char* hb = hbuf + (k & 1) * SSM_HB;
        bf16x8 Uf[8];
#pragma unroll
        for (int kt = 0; kt < 8; ++kt) Uf[kt] = *(const LAS bf16x8*)(ub + urd + kt * 64);
        f32x4 S = (f32x4){0.f, 0.f, 0.f, 0.f};
#pragma unroll
        for (int kt = 0; kt < 8; ++kt) S = __builtin_amdgcn_mfma_f32_16x16x32_bf16(Pf[kt], Uf[kt], S, 0, 0, 0);
        float vr[2] = {S[0], S[2]}, vi[2] = {S[1], S[3]};
#pragma unroll
        for (int s = 0; s < 2; ++s) {
            float sr, si, tr, ti;
            sr = dpp_shr0<0x111>(vr[s]); si = dpp_shr0<0x111>(vi[s]); cmul(l1r[s], l1i[s], sr, si, tr, ti); vr[s] += tr; vi[s] += ti;
            sr = dpp_shr0<0x112>(vr[s]); si = dpp_shr0<0x112>(vi[s]); cmul(l2r[s], l2i[s], sr, si, tr, ti); vr[s] += tr; vi[s] += ti;
            sr = dpp_shr0<0x114>(vr[s]); si = dpp_shr0<0x114>(vi[s]); cmul(l4r[s], l4i[s], sr, si, tr, ti); vr[s] += tr; vi[s] += ti;
            sr = dpp_shr0<0x118>(vr[s]); si = dpp_shr0<0x118>(vi[s]); cmul(l8r[s], l8i[s], sr, si, tr, ti); vr[s] += tr; vi[s] += ti;
        }
        float hin[4];
#pragma unroll
        for (int s = 0; s < 2; ++s) {
            float tr, ti; cmul(lnr[s], lni[s], h0r[s], h0i[s], tr, ti);
            hin[2 * s] = dpp_shr0<0x111>(vr[s]) + tr; hin[2 * s + 1] = dpp_shr0<0x111>(vi[s]) + ti;
            float cr_, ci_; cmul(l16r[s], l16i[s], h0r[s], h0i[s], cr_, ci_);
            h0r[s] = row_last(vr[s]) + cr_; h0i[s] = row_last(vi[s]) + ci_;
        }
        *(LAS unsigned long long*)(hb + hwr) = (unsigned long long)pk2(hin[0], hin[1]) | ((unsigned long long)pk2(hin[2], hin[3]) << 32);
        if (k < 15) *(LAS v4u*)(ubuf + ((k + 1) & 1) * SSM_UB + cdst) = cnext;
        __syncthreads();
        if (k < 14) cnext = *(const v4u*)(csrc + (size_t)(k + 2) * 256 * 256);
        bf16x8 Hf[4];
#pragma unroll
        for (int kq = 0; kq < 4; ++kq) Hf[kq] = *(const LAS bf16x8*)(hb + hrd + kq * 64);
        f32x4 yA = (f32x4){0.f, 0.f, 0.f, 0.f}, yB = (f32x4){0.f, 0.f, 0.f, 0.f};
#pragma unroll
        for (int kt = 0; kt < 4; ++kt) if (kt < nA) yA = __builtin_amdgcn_mfma_f32_16x16x32_bf16(TA[kt], Uf[kt], yA, 0, 0, 0);
#pragma unroll
        for (int kt = 0; kt < 8; ++kt) if (kt < nB) yB = __builtin_amdgcn_mfma_f32_16x16x32_bf16(TB[kt], Uf[kt], yB, 0, 0, 0);
#pragma unroll
        for (int kq = 0; kq < 4; ++kq) { yA = __builtin_amdgcn_mfma_f32_16x16x32_bf16(QA[kq], Hf[kq], yA, 0, 0, 0); yB = __builtin_amdgcn_mfma_f32_16x16x32_bf16(QB[kq], Hf[kq], yB, 0, 0, 0); }
        bf16* zr = Z + (rowb + k * 256 + n * 16) * 256 + g * 16 + 4 * q4;
        *(unsigned long long*)(zr + (size_t)mtA * 256) = (unsigned long long)pk2(gelu_fast(yA[0]), gelu_fast(yA[1])) | ((unsigned long long)pk2(gelu_fast(yA[2]), gelu_fast(yA[3])) << 32);
        *(unsigned long long*)(zr + (size_t)mtB * 256) = (unsigned long long)pk2(gelu_fast(yB[0]), gelu_fast(yB[1])) | ((unsigned long long)pk2(gelu_fast(yB[2]), gelu_fast(yB[3])) << 32);
    }
    __syncthreads();
}

constexpr int CONVW_OFF = 0;
__device__ __forceinline__ void conv_pre_stage(Frame& F, const Inputs& I, int l) {
    __syncthreads();
    const float* cw = I.p[13] + (size_t)l * CWID * 256;
    for (int i = F.tid; i < CWID * 64; i += 512) *(LAS f32x4*)(F.lds + CONVW_OFF + i * 16) = *(const f32x4*)(cw + 4 * i);
    __syncthreads();
}
__device__ __forceinline__ void conv_pre_run(Frame& F, const Inputs& I, int l, int row0) {
    const bf16* Uc = (const bf16*)(F.ws + WS_UC); bf16* Yc = (bf16*)(F.ws + WS_YC);
    const int c0 = 4 * F.lane;
    const f32x4 bias = *(const f32x4*)(I.p[14] + l * 256 + c0), g = *(const f32x4*)(I.p[15] + l * 256 + c0), bb = *(const f32x4*)(I.p[16] + l * 256 + c0);
    for (int blk = 0; blk < 4; ++blk) {
        const int r0 = row0 + 8 * blk, t0 = r0 & (SEQ - 1);
        unsigned long long uw[CWID + 7];
#pragma unroll
        for (int i = 0; i < CWID + 7; ++i) { const int tt = t0 - (CWID - 1) + i; const unsigned long long v = *(const unsigned long long*)(Uc + (size_t)(tt >= 0 ? r0 - (CWID - 1) + i : r0) * 256 + c0); uw[i] = tt >= 0 ? v : 0ull; }
        f32x4 a[8];
#pragma unroll
        for (int o = 0; o < 8; ++o) a[o] = bias;
#pragma unroll
        for (int j = 0; j < CWID; ++j) { const f32x4 w = *(const LAS f32x4*)(F.lds + CONVW_OFF + (j * 64 + F.lane) * 16);
#pragma unroll
            for (int o = 0; o < 8; ++o) { const unsigned long long u = uw[o + j];
                a[o].x += w.x * __uint_as_float((unsigned)u << 16); a[o].y += w.y * __uint_as_float((unsigned)u & 0xffff0000u);
                a[o].z += w.z * __uint_as_float((unsigned)(u >> 32) << 16); a[o].w += w.w * __uint_as_float((unsigned)(u >> 32) & 0xffff0000u); } }
#pragma unroll
        for (int o = 0; o < 8; ++o) {
            f32x4 av = a[o];
            const float mu = wave_sum((av.x + av.y) + (av.z + av.w), F.lane) * (1.0f / 256.0f);
            av = av - mu;
            const float var = wave_sum((av.x * av.x + av.y * av.y) + (av.z * av.z + av.w * av.w), F.lane) * (1.0f / 256.0f);
            const float rs = 1.0f / sqrtf(var + LN_EPS);
            f32x4 y = av * rs * g + bb;
            y.x = y.x / (1.0f + __expf(-y.x)); y.y = y.y / (1.0f + __expf(-y.y)); y.z = y.z / (1.0f + __expf(-y.z)); y.w = y.w / (1.0f + __expf(-y.w));
            *(unsigned long long*)(Yc + (size_t)(r0 + o) * 256 + c0) = (unsigned long long)pk2(y.x, y.y) | ((unsigned long long)pk2(y.z, y.w) << 32);
        }
    }
}
__device__ __forceinline__ void attn_norm_row(Frame& F, int row) {
    bf16* mix = (bf16*)(F.ws + WS_MIX) + (size_t)row * DM + 8 * F.lane;
    const v4u w = *(const v4u*)mix;
    float v[8] = {__uint_as_float(w.x << 16), __uint_as_float(w.x & 0xffff0000u), __uint_as_float(w.y << 16), __uint_as_float(w.y & 0xffff0000u), __uint_as_float(w.z << 16), __uint_as_float(w.z & 0xffff0000u), __uint_as_float(w.w << 16), __uint_as_float(w.w & 0xffff0000u)};
    float s = 0.f;
#pragma unroll
    for (int k = 0; k < 8; ++k) s += v[k] * v[k];
    const float rs = 1.0f / sqrtf(wave_sum(s, F.lane) * (1.0f / 512.0f) + RMS_EPS);
    v4u o; o.x = pk2(v[0] * rs, v[1] * rs); o.y = pk2(v[2] * rs, v[3] * rs); o.z = pk2(v[4] * rs, v[5] * rs); o.w = pk2(v[6] * rs, v[7] * rs);
    *(v4u*)mix = o;
}
__device__ __forceinline__ void final_norm_row(Frame& F, float* out, const float* gain, int row) {
    const bf16* hp = (const bf16*)(F.ws + WS_HB) + (size_t)row * DM + 8 * F.lane;
    float v[16]; float s = 0.f;
#pragma unroll
    for (int j = 0; j < 2; ++j) { const v4u w = *(const v4u*)(hp + 512 * j);
        v[8 * j + 0] = __uint_as_float(w.x << 16); v[8 * j + 1] = __uint_as_float(w.x & 0xffff0000u); v[8 * j + 2] = __uint_as_float(w.y << 16); v[8 * j + 3] = __uint_as_float(w.y & 0xffff0000u);
        v[8 * j + 4] = __uint_as_float(w.z << 16); v[8 * j + 5] = __uint_as_float(w.z & 0xffff0000u); v[8 * j + 6] = __uint_as_float(w.w << 16); v[8 * j + 7] = __uint_as_float(w.w & 0xffff0000u); }
#pragma unroll
    for (int k = 0; k < 16; ++k) s += v[k] * v[k];
    const float rs = 1.0f / sqrtf(wave_sum(s, F.lane) * (1.0f / DM) + RMS_EPS);
#pragma unroll
    for (int j = 0; j < 2; ++j) { const f32x4 g0 = *(const f32x4*)(gain + 512 * j + 8 * F.lane), g1 = *(const f32x4*)(gain + 512 * j + 8 * F.lane + 4);
        GAS f32x4* o = (GAS f32x4*)(out + (size_t)row * DM + 512 * j + 8 * F.lane);
        o[0] = (f32x4){v[8 * j] * rs * g0.x, v[8 * j + 1] * rs * g0.y, v[8 * j + 2] * rs * g0.z, v[8 * j + 3] * rs * g0.w};
        o[1] = (f32x4){v[8 * j + 4] * rs * g1.x, v[8 * j + 5] * rs * g1.y, v[8 * j + 6] * rs * g1.z, v[8 * j + 7] * rs * g1.w}; }
}

constexpr int KM_OFF = 86016;
static_assert(attn_body::ATTN_LDS_BYTES <= KM_OFF && KM_OFF + 4096 <= RING_BYTES, "attention LDS map");
__device__ __forceinline__ unsigned moba_gate(Frame& F, unsigned char* wsu, int b, int h, int qb) {
    LAS float* km = (LAS float*)(F.lds + KM_OFF);
    int tid = threadIdx.x; asm volatile("" : "+v"(tid)); const int lane = tid & 63;
    const float* kmp = (const float*)(wsu + WS_KMP);
    for (int i = tid; i < 16 * 64; i += 512) { const int n = i >> 6, d = i & 63; float v = 0.f;
        if (n < qb) { const size_t idx = ((size_t)(b * NBLK + n) * 512) + h * 64 + d; v = (kmp[idx] + kmp[(size_t)BATCH * NBLK * 512 + idx]) * (1.0f / 256.0f); }
        km[i] = v; }
    __syncthreads();
    const int r32 = lane & 31, hi = lane >> 5;
    const bf16* q = (const bf16*)(wsu + WS_QB) + ((size_t)b * SEQ + qb * 256 + F.wave * 32 + r32) * 512 + h * 64 + hi * 32;
    float g[15];
#pragma unroll
    for (int n = 0; n < 15; ++n) g[n] = 0.f;
#pragma unroll 2
    for (int d8 = 0; d8 < 4; ++d8) { const v4u qw = *(const v4u*)(q + 8 * d8);
        const float qv[8] = {__uint_as_float(qw.x << 16), __uint_as_float(qw.x & 0xffff0000u), __uint_as_float(qw.y << 16), __uint_as_float(qw.y & 0xffff0000u), __uint_as_float(qw.z << 16), __uint_as_float(qw.z & 0xffff0000u), __uint_as_float(qw.w << 16), __uint_as_float(qw.w & 0xffff0000u)};
#pragma unroll
        for (int n = 0; n < 15; ++n) { const LAS float* kk = km + n * 64 + hi * 32 + 8 * d8;
            g[n] += ((qv[0] * kk[0] + qv[1] * kk[1]) + (qv[2] * kk[2] + qv[3] * kk[3])) + ((qv[4] * kk[4] + qv[5] * kk[5]) + (qv[6] * kk[6] + qv[7] * kk[7])); } }
#pragma unroll
    for (int n = 0; n < 15; ++n) g[n] += shx(g[n], 32, lane);
    unsigned mask = 0u; const int topk = qb < 3 ? qb : 3;
    for (int k = 0; k < topk; ++k) { float best = -INFINITY; int bi = 0;
#pragma unroll
        for (int n = 0; n < 15; ++n) { const bool ok = n < qb && !((mask >> n) & 1u) && g[n] > best; best = ok ? g[n] : best; bi = ok ? n : bi; }
        mask |= 1u << bi; }
    return mask;
}

struct Args { Inputs in; float* out; unsigned char* ws; int ph_lo, ph_hi, li, pad; };
template <int PHM> __global__ void __launch_bounds__(NWAVES * 64, 2) skel_fwd(Args args) {
    extern __shared__ __attribute__((aligned(16))) unsigned char lds[];
#define FRAME() Frame F; { unsigned char* ws_ = args.ws; int t_ = threadIdx.x; asm volatile("" : "+s"(ws_), "+v"(t_)); F.lds = (LAS unsigned char*)lds; F.MISC = (volatile LAS unsigned*)(F.lds + MISC_OFF); \
        F.tid = t_; F.lane = t_ & 63; F.wave = __builtin_amdgcn_readfirstlane(t_ >> 6); F.G = gridDim.x; { const int bx = blockIdx.x; F.vcu = (F.G % 8 == 0) ? (bx % 8) * (F.G / 8) + bx / 8 : bx; } \
        F.ws = ws_; F.ctl = (gu32*)(ws_ + WS_CTL); } \
        bf16* const HB = (bf16*)(F.ws + WS_HB); float* const SSQ = (float*)(F.ws + WS_SSQ); bf16* const MIX = (bf16*)(F.ws + WS_MIX); const int gw = F.vcu * NWAVES + F.wave, NGW = F.G * NWAVES; (void)HB; (void)SSQ; (void)MIX; (void)gw; (void)NGW;
    LAS unsigned char* const lds0 = (LAS unsigned char*)lds;
    gu32* const ctl0 = (gu32*)(args.ws + WS_CTL);
    const Inputs& I = args.in;
    for (int u = threadIdx.x; u < (LDS_BYTES - LDSCTL_OFF) / 4; u += NWAVES * 64) ((LAS unsigned*)(lds0 + LDSCTL_OFF))[u] = 0u;
    __syncthreads();
    XcdBarrier bar; bar.bar = (unsigned*)(ctl0 + CW_BAR); bar.x = 0; bar.st = nullptr;
    if (MK_ONE_LAUNCH) bar = xcd_barrier_post((unsigned*)(ctl0 + CW_BAR), (volatile LAS unsigned*)(lds0 + MISC_OFF) + 8);
#define GRID_BAR() do { if (MK_ONE_LAUNCH) xcd_barrier(bar); } while (0)
    const int lo = args.ph_lo, hi = args.ph_hi;
#define PHON(t) (((PHM) >> (t)) & 1)
#define IN(k) (lo <= (k) && (k) < hi)
#define BOTH(k) (IN(k) && IN((k) + 1))

    if (PHON(0) && IN(0)) { FRAME(); for (int rep = 0; rep < NREP(0); ++rep) { p0_prologue(F, I); if (rep + 1 < NREP(0)) GRID_BAR(); } if (BOTH(0)) GRID_BAR(); }

    for (int l = 0; l < DEPTH; ++l) {
        const int pb = 1 + 6 * l;
#define WL() unsigned char* wl = F.ws + WS_W + (size_t)l * W_LAYER;
        if (PHON(1) && IN(pb)) { FRAME(); WL(); (void)wl;
            pg8::Gemm g{HB, (const bf16*)(wl + WO_IN), M, D_IN, DM}; pg8::StaticOrder S; S.init(M, D_IN, F.G, (int)blockIdx.x);
            pg8::EpiInProj E{SSQ, (const float*)(F.ws + WS_ROPE), (bf16*)(F.ws + WS_QB), (bf16*)(F.ws + WS_KB), (bf16*)(F.ws + WS_VB), (bf16*)(F.ws + WS_US), (bf16*)(F.ws + WS_UC), (float*)(F.ws + WS_QF), (float*)(F.ws + WS_KMP)};
            for (int rep = 0; rep < NREP(1); ++rep) { pg8::gemm_phase<pg8::EpiInProj, pg8::StaticOrder, true, true>(F.lds + RING_OFF, g, S, E); if (rep + 1 < NREP(1)) GRID_BAR(); }
            if (BOTH(pb)) GRID_BAR();
        }
        if (PHON(2) && IN(pb + 1)) { FRAME(); WL(); (void)wl;
            for (int rep = 0; rep < NREP(8); ++rep) if (F.vcu < BATCH * NGRP) {
#if SSM_NAIVE
                ssm_naive_unit(F, I, l, F.vcu / NGRP, F.vcu % NGRP);
#else
                { unsigned char* wsu = args.ws; asm volatile("" : "+s"(wsu)); ssm_mfma_unit(F, I, wsu, l, F.vcu / NGRP, F.vcu % NGRP); }
#endif
            }
            for (int rep = 0; rep < NREP(9); ++rep) {
                if (F.vcu >= BATCH * NGRP) { conv_pre_stage(F, I, l); const int nw = (F.G - BATCH * NGRP) * NWAVES, w0 = (F.vcu - BATCH * NGRP) * NWAVES + F.wave; for (int r = w0; r < M / 32; r += nw) conv_pre_run(F, I, l, r * 32); }
                if (F.G <= BATCH * NGRP) { conv_pre_stage(F, I, l); for (int r = gw; r < M / 32; r += NGW) conv_pre_run(F, I, l, r * 32); } }
            for (int rep = 0; rep < NREP(10); ++rep)
            for (int i = F.vcu; i < BATCH * NHEAD * NBLK; i += F.G) {
                const int j = i >> 8, v = i & 255, bh = v >> 2, c = v & 3, k = (j & 1) + 2 * c + 8 * (j >> 1); const int qb = (k & 1) ? 15 - (k >> 1) : (k >> 1);
#if ATTN_NAIVE
                attn_naive_unit(F, bh >> 3, bh & 7, qb);
#else
                { unsigned char* wsu = args.ws; asm volatile("" : "+s"(wsu));
                  const unsigned selbits = moba_gate(F, wsu, bh >> 3, bh & 7, qb);
                  attn_body::attn_unit<8>(bh >> 3, bh & 7, qb, selbits, (const attn_body::bf16*)(wsu + WS_QB), (const attn_body::bf16*)(wsu + WS_KB), (const attn_body::bf16*)(wsu + WS_VB), (attn_body::bf16*)(wsu + WS_MIX), (char*)lds + RING_OFF); }
#endif
            }
            if (BOTH(pb + 1)) GRID_BAR();
        }
        if (PHON(3) && IN(pb + 2)) { FRAME(); WL(); (void)wl;
            for (int rep = 0; rep < NREP(3); ++rep) {
            for (int r = gw; r < M; r += NGW) attn_norm_row(F, r);
            int K256 = 256; asm volatile("" : "+s"(K256));
            for (int i = F.vcu; i < 256; i += F.G) {
#ifndef TAIL_SKIP0
                if (i < 128) { pg8::Gemm g{(const bf16*)(F.ws + WS_Z), (const bf16*)(wl + WO_GLU), M, 256, K256}; pg8::OneUnit S{i, true};
                    pg8::EpiRowNorm<0> E{(const bf16*)(F.ws + WS_Z), I.p[12] + l * 256, MIX, 512};
                    pg8::gemm_phase<pg8::EpiRowNorm<0>, pg8::OneUnit, false, true>(F.lds + RING_OFF, g, S, E); }
#endif
#ifndef TAIL_SKIP1
                if (i >= 128) { pg8::Gemm g{(const bf16*)(F.ws + WS_YC), (const bf16*)(wl + WO_PW2), M, 256, K256}; pg8::OneUnit S{i - 128, true};
                    pg8::EpiRowNorm<1> E{nullptr, I.p[18] + l * 256, MIX, 768};
                    pg8::gemm_phase<pg8::EpiRowNorm<1>, pg8::OneUnit, false, true>(F.lds + RING_OFF, g, S, E); }
#endif
            }
            if (rep + 1 < NREP(3)) GRID_BAR(); }
            if (BOTH(pb + 2)) GRID_BAR();
        }
        if (PHON(4) && IN(pb + 3)) { FRAME(); WL(); (void)wl;
            pg8::Gemm g{MIX, (const bf16*)(wl + WO_OUT), M, DM, DM}; pg8::StaticOrder S; S.init(M, DM, F.G, (int)blockIdx.x);
            for (int rep = 0; rep < 1; ++rep) { pg8::EpiResid E{HB, SSQ};
            pg8::gemm_phase<pg8::EpiResid, pg8::StaticOrder, true, true>(F.lds + RING_OFF, g, S, E); }
            if (BOTH(pb + 3)) GRID_BAR();
        }
        if (PHON(5) && IN(pb + 4)) { FRAME(); WL(); (void)wl;
            pg8::Gemm g{HB, (const bf16*)(wl + WO_GU), M, D_GU, DM}; pg8::StaticOrder S; S.init(M, D_GU, F.G, (int)blockIdx.x);
            pg8::EpiSwiGlu E{SSQ, (bf16*)(F.ws + WS_ACT)};
#if defined(NULLEPI_GU)
            { pg8::EpiNull EN{(float*)(F.ws + WS_MIX)}; pg8::gemm_phase<pg8::EpiNull, pg8::StaticOrder, true, true>(F.lds + RING_OFF, g, S, EN); GRID_BAR(); }
#endif
            for (int rep = 0; rep < NREP(5); ++rep) { pg8::gemm_phase<pg8::EpiSwiGlu, pg8::StaticOrder, true, true>(F.lds + RING_OFF, g, S, E); if (rep + 1 < NREP(5)) GRID_BAR(); }
            if (BOTH(pb + 4)) GRID_BAR();
        }
        if (PHON(6) && IN(pb + 5)) { FRAME(); WL(); (void)wl;
            pg8::Gemm g{(const bf16*)(F.ws + WS_ACT), (const bf16*)(wl + WO_DN), M, DM, D_FF}; pg8::StaticOrder S; S.init(M, DM, F.G, (int)blockIdx.x);
            for (int rep = 0; rep < 1; ++rep) { pg8::EpiResid E{HB, SSQ};
            pg8::gemm_phase<pg8::EpiResid, pg8::StaticOrder, true, true>(F.lds + RING_OFF, g, S, E); }
            if (BOTH(pb + 5)) GRID_BAR();
        }
    }
    if (PHON(7) && IN(13)) { FRAME(); for (int rep = 0; rep < NREP(7); ++rep) for (int r = gw; r < M; r += NGW) final_norm_row(F, args.out, I.p[26], r); }
#undef IN
#undef BOTH
}

typedef void (*kern_t)(Args);
static int phase_type(int p) { return p == 0 ? 0 : (p == 13 ? 7 : 1 + (p - 1) % 6); }
extern "C" void kernel_launch(void* const* d_in, const int* in_sizes, int n_in, void* d_out, int out_size, void* d_ws, size_t ws_size, hipStream_t stream) {
    static int grid = 0;
#if MK_ONE_LAUNCH
    static const kern_t kerns[1] = {skel_fwd<0xff>}; constexpr int NK = 1;
#else
    static const kern_t kerns[8] = {skel_fwd<0x01>, skel_fwd<0x02>, skel_fwd<0x04>, skel_fwd<0x08>, skel_fwd<0x10>, skel_fwd<0x20>, skel_fwd<0x40>, skel_fwd<0x80>}; constexpr int NK = 8;
#endif
    if (grid == 0) {
        if (n_in != 27 || out_size != M * DM || ws_size < WS_END) { fprintf(stderr, "kernel_launch: unexpected shapes: n_in %d out %d ws %zu\n", n_in, out_size, ws_size); grid = -1; return; }
        int dev = 0, cus = 0;
        if (hipGetDevice(&dev) != hipSuccess || hipDeviceGetAttribute(&cus, hipDeviceAttributeMultiprocessorCount, dev) != hipSuccess) { grid = -1; return; }
        for (int k = 0; k < NK; ++k) if (hipFuncSetAttribute((const void*)kerns[k], hipFuncAttributeMaxDynamicSharedMemorySize, LDS_BYTES) != hipSuccess) { fprintf(stderr, "kernel_launch: hipFuncSetAttribute failed\n"); grid = -1; return; }
        (void)hipGetLastError();
        grid = cus;
    }
    if (grid < 0) return;
    if (hipMemsetAsync((char*)d_ws + WS_CTL, 0, CTL_ZERO_BYTES, stream) != hipSuccess) return;
    Args a{};
    for (int i = 0; i < 27; ++i) a.in.p[i] = (const float*)d_in[i];
    a.out = (float*)d_out; a.ws = (unsigned char*)d_ws;
#if MK_ONE_LAUNCH
    a.ph_lo = 0; a.ph_hi = N_PHASES; a.li = 0; hipLaunchKernelGGL(kerns[0], dim3(grid), dim3(NWAVES * 64), LDS_BYTES, stream, a);
#else
    for (int p = 0; p < N_PHASES; ++p) { a.ph_lo = p; a.ph_hi = p + 1; a.li = p; hipLaunchKernelGGL(kerns[phase_type(p)], dim3(grid), dim3(NWAVES * 64), LDS_BYTES, stream, a); }
#endif
}
```
